# Optimizing an MI355X kernel written in HIP

```python
import jax, jax.numpy as jnp
from jax import lax
import numpy as np

D_MODEL = 1024
BATCH = 16
SEQ = 4096
DEPTH = 1

A_HEADS = D_MODEL // 128
A_HEAD_DIM = 64
A_WIDTH = A_HEADS * A_HEAD_DIM
A_PATTERNS = ((128, 1), (512, 4), (2048, 16))
BLK = 128
NEG = -1e30
B_HEADS = D_MODEL // 256
B_EXPAND = 128
B_HEAD_V = 128
B_WIDTH_K = B_HEADS * B_EXPAND
B_WIDTH = B_HEADS * B_HEAD_V
B_CHUNK = 64
FFN_HIDDEN = ((8 * D_MODEL // 3 + 255) // 256) * 256
PLE_DIM = 256
EPS = 1e-6
IN_SIZES = (A_WIDTH, A_WIDTH, A_WIDTH,
            B_WIDTH_K, B_WIDTH_K, B_WIDTH, B_WIDTH,
            D_MODEL, D_MODEL)
IN_TOTAL = sum(IN_SIZES)
IN_SPLITS = [int(s) for s in np.cumsum(IN_SIZES)[:-1]]

kernel_name = "hybrid_dilated_attn_hgrn2_gated_merge"


def rmsnorm(x, g):
    xf = x.astype(jnp.float32)
    y = xf * lax.rsqrt(jnp.mean(xf * xf, axis=-1, keepdims=True) + EPS)
    return (y * g.astype(jnp.float32)).astype(x.dtype)


def _dilated_branch(q, k, v, window, dilation):
    B, H, S, Dh = q.shape
    span = window // dilation
    unit = dilation * BLK
    s_pad = -(-S // unit) * unit
    pad = s_pad - S
    L = s_pad // dilation
    nb = L // BLK

    def to_blocks(t):
        t = jnp.pad(t, ((0, 0), (0, 0), (pad, 0), (0, 0)))
        t = t.reshape(B, H, L, dilation, Dh).transpose(0, 1, 3, 2, 4)
        return t.reshape(B, H, dilation, nb, BLK, Dh)

    qb, kb, vb = to_blocks(q), to_blocks(k), to_blocks(v)

    def band(t):
        prev = jnp.pad(t[:, :, :, :-1], ((0, 0), (0, 0), (0, 0), (1, 0), (0, 0), (0, 0)))
        return jnp.concatenate([prev, t], axis=4)

    kk, vv = band(kb), band(vb)
    s = jnp.einsum("bhrnqd,bhrnkd->bhrnqk", qb, kk) * (Dh ** -0.5)
    a = jnp.arange(BLK)[:, None]
    c = jnp.arange(2 * BLK)[None, :]
    rel = a + BLK - c
    r = jnp.arange(dilation)[:, None, None, None]
    n = jnp.arange(nb)[None, :, None, None]
    key_pos = ((n - 1) * BLK + c) * dilation + r - pad
    mask = (rel >= 0) & (rel <= span) & (key_pos >= 0)
    s = jnp.where(mask, s, NEG)
    m = jnp.max(s, axis=-1)
    e = jnp.where(mask, jnp.exp(s - m[..., None]), 0.0)
    den = jnp.sum(e, axis=-1)
    num = jnp.einsum("bhrnqk,bhrnkd->bhrnqd", e, vv)

    def from_blocks(t):
        tail = t.shape[5:]
        t = t.reshape((B, H, dilation, L) + tail)
        t = jnp.swapaxes(t, 2, 3).reshape((B, H, s_pad) + tail)
        return t[:, :, pad:]

    return from_blocks(m), from_blocks(den), from_blocks(num)


def dilated_attention(qa, ka, va):
    B, S, _ = qa.shape
    heads = lambda t: t.astype(jnp.float32).reshape(B, S, A_HEADS, A_HEAD_DIM).transpose(0, 2, 1, 3)
    q, k, v = heads(qa), heads(ka), heads(va)
    ms, dens, nums = [], [], []
    for window, dilation in A_PATTERNS:
        m, den, num = _dilated_branch(q, k, v, window, dilation)
        ms.append(m); dens.append(den); nums.append(num)
    ms = jnp.stack(ms); dens = jnp.stack(dens); nums = jnp.stack(nums)
    w = jnp.exp(ms - jnp.max(ms, axis=0, keepdims=True))
    out = jnp.sum(w[..., None] * nums, axis=0) / jnp.sum(w * dens, axis=0)[..., None]
    return out.transpose(0, 2, 1, 3).reshape(B, S, A_WIDTH).astype(qa.dtype)


def hgrn2(qb, fb, ib, gb, lb, g_norm):
    B, S, _ = qb.shape
    heads = lambda t: t.astype(jnp.float32).reshape(B, S, B_HEADS, -1)
    lb = lb.astype(jnp.float32).reshape(B_HEADS, B_EXPAND)
    q = heads(qb)
    f = lb + (1.0 - lb) * jax.nn.sigmoid(heads(fb))
    k = 1.0 - f
    logf = jnp.log(f)
    v = heads(ib)
    nc = S // B_CHUNK
    chunks = lambda t: t.reshape(B, nc, B_CHUNK, B_HEADS, -1).transpose(1, 0, 3, 2, 4)
    tril = jnp.tril(jnp.ones((B_CHUNK, B_CHUNK), dtype=bool))[:, :, None]

    def step(state, inp):
        qc, kc, vc, gc = inp
        b = jnp.cumsum(gc, axis=2)
        inter = jnp.einsum("bhtk,bhkv->bhtv", qc * jnp.exp(b), state)
        diff = b[:, :, :, None, :] - b[:, :, None, :, :]
        decay = jnp.exp(jnp.where(tril, diff, -jnp.inf))
        scores = jnp.einsum("bhtk,bhsk,bhtsk->bhts", qc, kc, decay)
        intra = jnp.einsum("bhts,bhsv->bhtv", scores, vc)
        b_end = b[:, :, -1, :]
        new_state = jnp.exp(b_end)[..., None] * state + jnp.einsum(
            "bhsk,bhsv->bhkv", kc * jnp.exp(b_end[:, :, None, :] - b), vc)
        return new_state, inter + intra

    state0 = jnp.zeros((B, B_HEADS, B_EXPAND, B_HEAD_V), jnp.float32)
    _, o = lax.scan(step, state0, (chunks(q), chunks(k), chunks(v), chunks(logf)))
    o = o.transpose(1, 0, 3, 2, 4).reshape(B, S, B_HEADS, B_HEAD_V)
    o = rmsnorm(o, g_norm) * jax.nn.silu(heads(gb))
    return o.reshape(B, S, B_WIDTH).astype(qb.dtype)


def setup_inputs(seed: int = 0) -> dict:
    key = jax.random.key(seed)
    ks = jax.random.split(key, 20)
    nrm = lambda k, shape, fan_in: jax.random.normal(k, shape, jnp.float32) * (fan_in ** -0.5)
    gain = lambda k, shape: 1.0 + 0.01 * jax.random.normal(k, shape, jnp.float32)
    return {
        "x": jax.random.normal(ks[0], (BATCH, SEQ, D_MODEL), jnp.float32),
        "p": jax.random.normal(ks[1], (DEPTH, BATCH, SEQ, PLE_DIM), jnp.float32),
        "norm_mix": gain(ks[2], (DEPTH, D_MODEL)),
        "w_in": nrm(ks[3], (DEPTH, D_MODEL, IN_TOTAL), D_MODEL),
        "hg_lb": 0.1 * jax.random.normal(ks[4], (DEPTH + 1, B_WIDTH_K), jnp.float32),
        "hg_norm": gain(ks[5], (DEPTH, B_HEAD_V)),
        "w_a_up": nrm(ks[6], (DEPTH, A_WIDTH, D_MODEL), A_WIDTH),
        "w_b_up": nrm(ks[7], (DEPTH, B_WIDTH, D_MODEL), B_WIDTH),
        "w_out": nrm(ks[8], (DEPTH, D_MODEL, D_MODEL), D_MODEL),
        "norm_ffn": gain(ks[9], (DEPTH, D_MODEL)),
        "w_gu": nrm(ks[10], (DEPTH, D_MODEL, 2 * FFN_HIDDEN), D_MODEL),
        "w_down": nrm(ks[11], (DEPTH, FFN_HIDDEN, D_MODEL), FFN_HIDDEN),
        "norm_ple": gain(ks[12], (DEPTH, D_MODEL)),
        "w_pe": nrm(ks[13], (DEPTH, PLE_DIM, D_MODEL), PLE_DIM),
        "w_pg": nrm(ks[14], (DEPTH, D_MODEL, D_MODEL), D_MODEL),
        "norm_final": gain(ks[15], (D_MODEL,)),
    }


def reference(x, p, norm_mix, w_in, hg_lb, hg_norm, w_a_up, w_b_up, w_out, norm_ffn,
              w_gu, w_down, norm_ple, w_pe, w_pg, norm_final):
    lb_all = jnp.cumsum(jax.nn.softmax(hg_lb.astype(jnp.float32), axis=0), axis=0)
    for i in range(DEPTH):
        h = rmsnorm(x, norm_mix[i])
        proj = h @ w_in[i]
        qa, ka, va, qb, fb, ib, gb, gate_a, gate_b = jnp.split(proj, IN_SPLITS, axis=-1)
        ya = dilated_attention(qa, ka, va)
        yb = hgrn2(qb, fb, ib, gb, lb_all[i], hg_norm[i])
        merged = jax.nn.sigmoid(gate_a) * (ya @ w_a_up[i]) + jax.nn.sigmoid(gate_b) * (yb @ w_b_up[i])
        x = x + merged @ w_out[i]
        h = rmsnorm(x, norm_ffn[i])
        g, u = jnp.split(h @ w_gu[i], 2, axis=-1)
        x = x + (jax.nn.silu(g) * u) @ w_down[i]
        hp = rmsnorm(x, norm_ple[i])
        x = x + (p[i] @ w_pe[i]) * jax.nn.sigmoid(hp @ w_pg[i])
    return rmsnorm(x, norm_final)
```

```cpp
#include <hip/hip_runtime.h>
#include <cstdio>
#include <cstdint>
namespace pg8 {
#define PG8_LAS __attribute__((address_space(3)))
typedef unsigned short bf16_t;
typedef short bf16x8 __attribute__((ext_vector_type(8)));
typedef float f32x4 __attribute__((ext_vector_type(4)));
typedef unsigned u32x4 __attribute__((ext_vector_type(4)));
constexpr int BM = 256, BK = 64, HALF = 128, HTB = HALF * BK * 2  , STAGE_BYTES = 8 * HTB, NXCD = 8, WGM = 8;

__host__ __device__ __forceinline__ int lds_byte(int r, int c) { const int st = (r >> 4) * 2 + (c >> 5), rr = r & 15, cc = c & 31, ob = rr * 64 + cc * 2; return st * 1024 + (ob ^ (((ob >> 9) & 1) << 5)); }
__host__ __device__ __forceinline__ void stage_rc(int b, int& R, int& C) { const int st = b / 1024, sb = b % 1024, swz = sb ^ (((sb >> 9) & 1) << 5); R = (st >> 1) * 16 + swz / 64; C = (st & 1) * 32 + (swz % 64) / 2; }
__host__ __device__ __forceinline__ int perm32(int rho) { const int n = rho >> 4, i = rho & 15; return 8 * (i >> 2) + 4 * n + (i & 3); }

struct Unit { int pm, pn, ks; };
struct Gemm { const bf16_t* A; const bf16_t* Bt; int M, N, K, ld; };

struct StaticOrder {
    int nM, nN, nwg, G, c;
    __host__ __device__ void init(int M, int N, int G_, int c_) { nM = M / BM; nN = N / BM; nwg = nM * nN; G = G_; c = c_; }
    __host__ __device__ bool next(int i, Unit& u) const {
        const long L = (long)i * G + c; if (L >= nwg) return false;
        int wgid = (int)L; { const int q = nwg / NXCD, r = nwg % NXCD, xcd = wgid % NXCD, off = wgid / NXCD; wgid = (xcd < r ? xcd * (q + 1) : r * (q + 1) + (xcd - r) * q) + off; }
        const int nig = WGM * nN, gid = wgid / nig, fm = gid * WGM, gsz = (nM - fm) < WGM ? (nM - fm) : WGM;
        u.pm = fm + ((wgid % nig) % gsz); u.pn = (wgid % nig) / gsz; u.ks = 0; return true;
    }
    __device__ __forceinline__ void a_ready(const Unit&) const {}
    __device__ __forceinline__ void done(const Unit&) const {}
};
struct SplitOrder : StaticOrder {
    __host__ __device__ bool next(int i, Unit& u) const { if (!StaticOrder::next(i >> 1, u)) return false; u.ks = i & 1; return true; }
};

__device__ __forceinline__ unsigned cvt_pk_bf16(float lo, float hi) { unsigned r; asm volatile("v_cvt_pk_bf16_f32 %0, %1, %2" : "=v"(r) : "v"(lo), "v"(hi)); return r; }
template <class Epi, class Sched, bool ALIGN_EPI = false, bool SP2 = false>
__device__ __forceinline__ void gemm_phase(PG8_LAS unsigned char* lds, const Gemm g, const Sched& S, const Epi& E) {
    int tid_ = threadIdx.x; asm volatile("" : "+v"(tid_));
    const int tid = tid_, wid = __builtin_amdgcn_readfirstlane(tid >> 6), lane = tid & 63, wr = wid >> 2, wc = wid & 3, fr = lane & 15, fq = lane >> 4;
    const int K = g.K, nt = K / BK, ld = g.ld ? g.ld : K;
    unsigned voffA[2], voffB[2];
#pragma unroll
    for (int i = 0; i < 2; ++i) { int R, C; stage_rc(tid * 16 + i * 8192, R, C); const int Rb = Epi::PERM ? ((R & ~31) + perm32(R & 31)) : R;
        voffA[i] = (unsigned)(R * ld + C) * 2u; voffB[i] = (unsigned)(Rb * ld + C) * 2u; }
    const size_t kstep = (size_t)(BK * 2);
    const size_t hstep = (size_t)HALF * ld * 2;
    const size_t tstep = 2 * hstep;
    const unsigned ldsw = (unsigned)wid * 1024u;
    const int aoff = lds_byte(wr * 64 + fr, fq * 8), boff = lds_byte(wc * 32 + fr, fq * 8);
#define PG8_SA(b, h) (((b) * 2 + (h)) * HTB)
#define PG8_SB(b, h) ((4 + (b) * 2 + (h)) * HTB)
#define PG8_STAGE(bufoff, gbase, voff) do { _Pragma("unroll") for (int _i = 0; _i < 2; ++_i) \
        __builtin_amdgcn_global_load_lds((const unsigned*)((const char*)(gbase) + (voff)[_i]), (PG8_LAS unsigned*)(lds + (bufoff) + ldsw + _i * 8192), 16, 0, 0); } while (0)
#define PG8_LDA(dst, b, h) do { _Pragma("unroll") for (int m = 0; m < 4; ++m) _Pragma("unroll") for (int k = 0; k < 2; ++k) dst[m][k] = *(const PG8_LAS bf16x8*)(lds + PG8_SA(b, h) + aoff + m * 2048 + k * 1024); } while (0)
#define PG8_LDB(dst, b, h) do { _Pragma("unroll") for (int n = 0; n < 2; ++n) _Pragma("unroll") for (int k = 0; k < 2; ++k) dst[n][k] = *(const PG8_LAS bf16x8*)(lds + PG8_SB(b, h) + boff + n * 2048 + k * 1024); } while (0)
#define PG8_MMA(ai, bj, At, Bt) do { __builtin_amdgcn_s_setprio(1); _Pragma("unroll") for (int m = 0; m < 4; ++m) _Pragma("unroll") for (int n = 0; n < 2; ++n) _Pragma("unroll") for (int k = 0; k < 2; ++k) \
        acc[ai][bj][m][n] = __builtin_amdgcn_mfma_f32_16x16x32_bf16(Bt[n][k], At[m][k], acc[ai][bj][m][n], 0, 0, 0); __builtin_amdgcn_s_setprio(0); } while (0)
#define PG8_WAIT_V(n) asm volatile("s_waitcnt vmcnt(" #n ")" ::: "memory")
#define PG8_WAIT_L(n) asm volatile("s_waitcnt lgkmcnt(" #n ")" ::: "memory")
#define PG8_BAR __builtin_amdgcn_s_barrier()
#define PG8_SCHED __builtin_amdgcn_sched_barrier(0)
    Unit cur, nxt; int ui = 0;
    if (!S.next(0, cur)) return;
    f32x4 acc[2][2][4][2];
#pragma unroll
    for (int a = 0; a < 2; ++a)
#pragma unroll
        for (int b = 0; b < 2; ++b)
#pragma unroll
            for (int m = 0; m < 4; ++m)
#pragma unroll
                for (int n = 0; n < 2; ++n) acc[a][b][m][n] = (f32x4){0.f, 0.f, 0.f, 0.f};
    bf16x8 At[4][2], B0[2][2], B1[2][2];
    const char* cA = (const char*)g.A + (size_t)cur.pm * tstep + (size_t)cur.ks * K * 2; const char* cB = (const char*)g.Bt + (size_t)cur.pn * tstep + (size_t)cur.ks * K * 2;
    S.a_ready(cur);
    if constexpr (SP2) {
        PG8_STAGE(PG8_SB(0, 0), cB, voffB); PG8_STAGE(PG8_SB(0, 1), cB + hstep, voffB); PG8_STAGE(PG8_SA(0, 0), cA, voffA); PG8_STAGE(PG8_SA(0, 1), cA + hstep, voffA);
        if (wr == 1) PG8_BAR;
        PG8_WAIT_V(2); PG8_BAR;
        PG8_STAGE(PG8_SB(1, 0), cB + kstep, voffB); PG8_STAGE(PG8_SA(1, 0), cA + kstep, voffA); PG8_STAGE(PG8_SB(1, 1), cB + hstep + kstep, voffB);
        PG8_WAIT_V(6); PG8_BAR;
    } else {
        PG8_STAGE(PG8_SB(0, 0), cB, voffB); PG8_STAGE(PG8_SA(0, 0), cA, voffA); PG8_STAGE(PG8_SB(0, 1), cB + hstep, voffB); PG8_STAGE(PG8_SA(0, 1), cA + hstep, voffA);
        if (wr == 1) PG8_BAR;
        PG8_WAIT_V(4); PG8_BAR;
        PG8_STAGE(PG8_SB(1, 0), cB + kstep, voffB); PG8_STAGE(PG8_SA(1, 0), cA + kstep, voffA); PG8_STAGE(PG8_SB(1, 1), cB + hstep + kstep, voffB);
        PG8_WAIT_V(6); PG8_BAR;
    }
    for (;;) {
        const bool has_next = S.next(ui + 1, nxt);
        const char* nA = has_next ? (const char*)g.A + (size_t)nxt.pm * tstep + (size_t)nxt.ks * K * 2 : cA; const char* nB = has_next ? (const char*)g.Bt + (size_t)nxt.pn * tstep + (size_t)nxt.ks * K * 2 : cB;
#pragma nounroll
        for (int t = 0; t < nt; t += 2) {
            const bool last = (t == nt - 2);
            const char* a1 = cA + (size_t)(t + 1) * kstep;
            const char* a2 = last ? nA : cA + (size_t)(t + 2) * kstep; const char* b2 = last ? nB : cB + (size_t)(t + 2) * kstep;
            const char* a3 = a2 + kstep; const char* b3 = b2 + kstep;
            if (last && has_next) S.a_ready(nxt);
            if constexpr (SP2) {
            PG8_LDB(B0, 0, 0); PG8_LDB(B1, 0, 1); PG8_SCHED; PG8_LDA(At, 0, 0); PG8_STAGE(PG8_SA(1, 1), a1 + hstep, voffA);
            PG8_WAIT_V(8); PG8_WAIT_L(0); PG8_BAR; PG8_MMA(0, 0, At, B0); PG8_MMA(0, 1, At, B1); PG8_BAR; PG8_SCHED;
            PG8_LDA(At, 0, 1); PG8_STAGE(PG8_SB(0, 0), b2, voffB); PG8_STAGE(PG8_SB(0, 1), b2 + hstep, voffB); PG8_STAGE(PG8_SA(0, 0), a2, voffA);
            PG8_WAIT_V(8); PG8_WAIT_L(0); PG8_BAR; PG8_MMA(1, 0, At, B0); PG8_MMA(1, 1, At, B1); PG8_BAR; PG8_SCHED;
            PG8_LDB(B0, 1, 0); PG8_LDB(B1, 1, 1); PG8_SCHED; PG8_LDA(At, 1, 0); PG8_STAGE(PG8_SA(0, 1), a2 + hstep, voffA);
            PG8_WAIT_V(8); PG8_WAIT_L(0); PG8_BAR; PG8_MMA(0, 0, At, B0); PG8_MMA(0, 1, At, B1); PG8_BAR; PG8_SCHED;
            PG8_LDA(At, 1, 1); PG8_STAGE(PG8_SB(1, 0), b3, voffB); PG8_STAGE(PG8_SB(1, 1), b3 + hstep, voffB); PG8_STAGE(PG8_SA(1, 0), a3, voffA);
            PG8_WAIT_V(8); PG8_WAIT_L(0); PG8_BAR; PG8_MMA(1, 0, At, B0); PG8_MMA(1, 1, At, B1); PG8_BAR; PG8_SCHED;
            } else {
            PG8_LDB(B0, 0, 0); PG8_SCHED; PG8_LDA(At, 0, 0); PG8_STAGE(PG8_SA(1, 1), a1 + hstep, voffA);
            PG8_WAIT_L(8); PG8_BAR; PG8_WAIT_L(0); PG8_MMA(0, 0, At, B0); PG8_BAR; PG8_SCHED;
            PG8_LDB(B1, 0, 1); PG8_STAGE(PG8_SB(0, 0), b2, voffB);
            PG8_BAR; PG8_WAIT_L(0); PG8_MMA(0, 1, At, B1); PG8_BAR;
            PG8_LDA(At, 0, 1); PG8_STAGE(PG8_SA(0, 0), a2, voffA);
            PG8_BAR; PG8_WAIT_L(0); PG8_MMA(1, 0, At, B0); PG8_BAR; PG8_SCHED;
            PG8_STAGE(PG8_SB(0, 1), b2 + hstep, voffB);
            PG8_WAIT_V(6); PG8_BAR; PG8_MMA(1, 1, At, B1); PG8_BAR;
            PG8_LDB(B0, 1, 0); PG8_SCHED; PG8_LDA(At, 1, 0); PG8_STAGE(PG8_SA(0, 1), a2 + hstep, voffA);
            PG8_WAIT_L(8); PG8_BAR; PG8_WAIT_L(0); PG8_MMA(0, 0, At, B0); PG8_BAR; PG8_SCHED;
            PG8_LDB(B1, 1, 1); PG8_STAGE(PG8_SB(1, 0), b3, voffB);
            PG8_BAR; PG8_WAIT_L(0); PG8_MMA(0, 1, At, B1); PG8_BAR;
            PG8_LDA(At, 1, 1); PG8_STAGE(PG8_SA(1, 0), a3, voffA);
            PG8_BAR; PG8_WAIT_L(0); PG8_MMA(1, 0, At, B0); PG8_BAR; PG8_SCHED;
            PG8_STAGE(PG8_SB(1, 1), b3 + hstep, voffB);
            PG8_WAIT_V(6); PG8_BAR; PG8_MMA(1, 1, At, B1); PG8_BAR;
            }
        }
        if constexpr (ALIGN_EPI) { if (wr == 0) PG8_BAR; }
        bool keep_acc = false;
        if constexpr (Epi::KSPLIT) { if (cur.ks == 0) { E.mid(acc, cur, wr, wc, fr, fq); keep_acc = true; } }
        if constexpr (!Epi::AFTER_DRAIN) { if (!keep_acc) { E(acc, cur, wr, wc, fr, fq); S.done(cur); } }
        if (!has_next) break;
        if (!keep_acc)
#pragma unroll
        for (int a = 0; a < 2; ++a)
#pragma unroll
            for (int b = 0; b < 2; ++b)
#pragma unroll
                for (int m = 0; m < 4; ++m)
#pragma unroll
                    for (int n = 0; n < 2; ++n) acc[a][b][m][n] = (f32x4){0.f, 0.f, 0.f, 0.f};
        cur = nxt; cA = nA; cB = nB; ++ui;
        if constexpr (ALIGN_EPI) { if (wr == 1) PG8_BAR; }
    }
    PG8_WAIT_V(0);
    if constexpr (!ALIGN_EPI) { if (wr == 0) PG8_BAR; }
    PG8_BAR;
    if constexpr (Epi::AFTER_DRAIN) { E.fused(acc, cur, wr, wc, fr, fq, lds, wid, lane); S.done(cur); }
#undef PG8_SA
#undef PG8_SB
#undef PG8_STAGE
#undef PG8_LDA
#undef PG8_LDB
#undef PG8_MMA
#undef PG8_WAIT_V
#undef PG8_WAIT_L
#undef PG8_BAR
#undef PG8_SCHED
}
}
constexpr int BATCH = 16, SEQ = 4096, D = 1024, M = BATCH * SEQ;
constexpr int NIN = 5632, FF = 2816, PLE = 256;
constexpr int ATTW = 1536, HGW = 2048, GW = 2048;
constexpr float EPS = 1e-6f;
constexpr float QSCALE = 0.125f * 1.4426950408889634f;
constexpr int NWAVES = 8, NTHR = NWAVES * 64;

constexpr size_t MiB = 1u << 20;
constexpr size_t WS_CTL = 0, CTL_ZERO_BYTES = 1 * MiB;
constexpr size_t WS_WIN = 2 * MiB, WS_WGU = 13 * MiB, WS_WDN = 24 * MiB, WS_WOUT = 30 * MiB, WS_WPG = 32 * MiB, WS_WA = 34 * MiB, WS_WB = 35 * MiB, WS_WPE = 36 * MiB;
constexpr size_t WS_RSTD0 = 37 * MiB;
constexpr size_t WS_LSE = 40 * MiB;
constexpr size_t WS_PB = 48 * MiB;
constexpr size_t WS_XB = 80 * MiB;
constexpr size_t WS_YA = 80 * MiB, WS_YB = 80 * MiB;
constexpr size_t WS_ATT = 208 * MiB;
constexpr size_t WS_HG = 400 * MiB;
constexpr size_t WS_GT = 656 * MiB;
constexpr size_t WS_EST = 912 * MiB;
constexpr size_t WS_DCH = 45 * MiB;
constexpr size_t WS_DSEG = 44 * MiB;
constexpr size_t WS_END = 1024 * MiB;
constexpr int CW_BAR = 4096;
constexpr int CW_SS1 = 65536, CW_SS2 = 2 * 65536, CW_SS3 = 3 * 65536;

constexpr int RING_OFF = 0, RING_BYTES = 131072;
constexpr int LDSCTL_OFF = RING_BYTES, MISC_OFF = LDSCTL_OFF + 320;
constexpr int LDS_BYTES = 163840;

#define GAS __attribute__((address_space(1)))
#define LAS __attribute__((address_space(3)))
#define DI __device__ __forceinline__
typedef unsigned short bf16;
typedef unsigned v4u __attribute__((ext_vector_type(4)));
typedef unsigned v2u __attribute__((ext_vector_type(2)));
typedef float f32x4 __attribute__((ext_vector_type(4)));
typedef GAS unsigned gu32;
#define RLX_AGENT __ATOMIC_RELAXED, __HIP_MEMORY_SCOPE_AGENT
#define LDS_WAIT() asm volatile("s_waitcnt lgkmcnt(0)" ::: "memory")
#define VM_WAIT() asm volatile("s_waitcnt vmcnt(0)" ::: "memory")
DI unsigned f2bf(float f) { unsigned u = __builtin_bit_cast(unsigned, f); return (u + 0x7fffu + ((u >> 16) & 1u)) >> 16; }
DI unsigned pk2(float lo, float hi) { return f2bf(lo) | (f2bf(hi) << 16); }
DI float bflo(unsigned u) { return __builtin_bit_cast(float, u << 16); }
DI float bfhi(unsigned u) { return __builtin_bit_cast(float, u & 0xffff0000u); }
DI float bf2f(bf16 b) { return __builtin_bit_cast(float, (unsigned)b << 16); }
DI float sigmoidf_(float v) { return __builtin_amdgcn_rcpf(1.0f + __expf(-v)); }

#define XB_TMO      128
#define XB_XCNT(j)  (256  + 64 * (j))
#define XB_XSUB(j)  (1280 + 64 * (j))
#define XB_XGEN(j)  (2304 + 64 * (j))
#define XB_TOP      3328
#define XB_TOPGEN   3392
#define XCD_BAR_WORDS 3456
#define XB_SPIN_CAP (1u << 18)

__device__ __forceinline__ unsigned xb_ld(unsigned* p)              { return __hip_atomic_load(p, __ATOMIC_RELAXED, __HIP_MEMORY_SCOPE_AGENT); }
__device__ __forceinline__ unsigned xb_add(unsigned* p, unsigned v) { return __hip_atomic_fetch_add(p, v, __ATOMIC_RELAXED, __HIP_MEMORY_SCOPE_AGENT); }
__device__ __forceinline__ unsigned xb_xcc_id() { return (unsigned)__builtin_amdgcn_s_getreg((3 << 11) | 20) & 0xFu; }
#define XB_SPIN(cond, bar) do { unsigned _sp = 0; while (cond) { __builtin_amdgcn_s_sleep(1); \
    if ((++_sp & 255u) == 0u) { if (xb_ld(&(bar)[XB_TMO])) break; if (_sp > XB_SPIN_CAP) { atomicAdd(&(bar)[XB_TMO], 1u); break; } } } } while (0)

struct XcdBarrier {
    unsigned* bar; unsigned x;
    volatile LAS unsigned* st;
};

__device__ __forceinline__ XcdBarrier xcd_barrier_post(unsigned* bar, volatile LAS unsigned* st) {
    XcdBarrier b; b.bar = bar; b.x = xb_xcc_id(); b.st = st;
    if (threadIdx.x == 0) (void)xb_add(&bar[XB_XCNT(b.x)], 1u);
    return b;
}
__device__ __forceinline__ void xcd_barrier_complete(unsigned* bar, unsigned x, unsigned& nloc, unsigned& nx) {
    const unsigned G = gridDim.x * gridDim.y * gridDim.z;
    unsigned sum, cnt, mine, sp = 0u;
    for (;;) {
        sum = 0u; cnt = 0u; mine = 0u;
#pragma unroll
        for (unsigned j = 0; j < 16; ++j) { const unsigned c = xb_ld(&bar[XB_XCNT(j)]); sum += c; cnt += (c > 0u) ? 1u : 0u; mine = (j == x) ? c : mine; }
        if (sum == G) break;
        __builtin_amdgcn_s_sleep(1);
        if ((++sp & 255u) == 0u) { if (xb_ld(&bar[XB_TMO])) break; if (sp > XB_SPIN_CAP) { atomicAdd(&bar[XB_TMO], 1u); break; } }
    }
    nloc = mine > 0u ? mine : 1u; nx = cnt > 0u ? cnt : 1u;
}

__device__ __forceinline__ void xcd_barrier(const XcdBarrier& b) {
    asm volatile("s_waitcnt vmcnt(0)" ::: "memory");
    __syncthreads();
    if (threadIdx.x == 0) {
        unsigned* bar = b.bar;
        __builtin_amdgcn_s_waitcnt(0);
        unsigned nloc = b.st[0], nx = b.st[1];
        if (nloc == 0u) { xcd_barrier_complete(bar, b.x, nloc, nx); b.st[0] = nloc; b.st[1] = nx; }
        const unsigned old = xb_add(&bar[XB_XSUB(b.x)], 1u);
        const unsigned gen = old / nloc;
        if (old + 1u == (gen + 1u) * nloc) {
            __builtin_amdgcn_fence(__ATOMIC_RELEASE, "agent");
            asm volatile("s_waitcnt vmcnt(0)" ::: "memory");
            const unsigned og = xb_add(&bar[XB_TOP], 1u);
            const unsigned tg = og / nx;
            if (og + 1u == (tg + 1u) * nx) xb_add(&bar[XB_TOPGEN], 1u);
            else XB_SPIN(xb_ld(&bar[XB_TOPGEN]) == tg, bar);
            __builtin_amdgcn_fence(__ATOMIC_ACQUIRE, "agent");
            xb_add(&bar[XB_XGEN(b.x)], 1u);
            asm volatile("s_waitcnt vmcnt(0)" ::: "memory");
        } else {
            XB_SPIN(xb_ld(&bar[XB_XGEN(b.x)]) == gen, bar);
            __builtin_amdgcn_fence(__ATOMIC_ACQUIRE, "agent");
            asm volatile("s_waitcnt vmcnt(0)" ::: "memory");
        }
    }
    __syncthreads();
}

struct EpiArgs {
    const float* rs;
    float* ss;
    const float* xres;
    const bf16* xrb;
    bf16* ob;
    const bf16* gate;
    bf16* att; bf16* hg; bf16* g;
    const float* hg_lb; float* dch;
};
DI void unpack8(const v4u q, float (&f)[8]) { f[0] = bflo(q.x); f[1] = bfhi(q.x); f[2] = bflo(q.y); f[3] = bfhi(q.y); f[4] = bflo(q.z); f[5] = bfhi(q.z); f[6] = bflo(q.w); f[7] = bfhi(q.w); }
DI v4u pack8(const float (&f)[8]) { v4u w; w.x = pg8::cvt_pk_bf16(f[0], f[1]); w.y = pg8::cvt_pk_bf16(f[2], f[3]); w.z = pg8::cvt_pk_bf16(f[4], f[5]); w.w = pg8::cvt_pk_bf16(f[6], f[7]); return w; }

DI void st16_wt(void* p, v4u v) { asm volatile("global_store_dwordx4 %0, %1, off sc1\n\ts_nop 1" :: "v"(p), "v"(v) : "memory"); }
#ifndef WT_STORES
#define WT_STORES 0
#endif
#if WT_STORES == 1
#define ST16(p, v) st16_wt((void*)(p), (v))
#elif WT_STORES == 2
#define ST16(p, v) __builtin_nontemporal_store((v), (v4u*)(p))
#else
#define ST16(p, v) (*(v4u*)(p) = (v))
#endif
template <int N> DI float row_shr(float v) { return __builtin_bit_cast(float, __builtin_amdgcn_update_dpp(0, __builtin_bit_cast(int, v), 0x110 + N, 0xf, 0xf, true)); }
DI float row_last(float v, int lane) { return __builtin_bit_cast(float, __builtin_amdgcn_ds_bpermute((lane | 15) << 2, __builtin_bit_cast(int, v))); }

template <int MODE> struct Epi {
    static constexpr bool PERM = true, AFTER_DRAIN = false;
    static constexpr bool KSPLIT = (MODE == 2);
    EpiArgs a;
    DI void mid(pg8::f32x4 (&acc)[2][2][4][2], const pg8::Unit& u, int wr, int wc, int fr, int fq) const {
        const bf16* gbase = a.gate + (size_t)(u.pm * 256 + wr * 64 + fr) * GW + u.pn * 256 + wc * 32 + 8 * fq;
#pragma unroll
        for (int ai = 0; ai < 2; ++ai)
#pragma unroll
            for (int m = 0; m < 4; ++m)
#pragma unroll
                for (int bj = 0; bj < 2; ++bj) {
                    const bf16* gp = gbase + (size_t)(ai * 128 + m * 16) * GW + bj * 128;
                    float ga[8], gb[8]; unpack8(*(const v4u*)gp, ga); unpack8(*(const v4u*)(gp + 1024), gb);
#pragma unroll
                    for (int i = 0; i < 4; ++i) { acc[ai][bj][m][0][i] *= ga[i] * __builtin_amdgcn_rcpf(fmaxf(gb[i], 1e-30f)); acc[ai][bj][m][1][i] *= ga[4 + i] * __builtin_amdgcn_rcpf(fmaxf(gb[4 + i], 1e-30f)); }
                }
    }
    DI void hgrn_tile(const pg8::f32x4 (&acc)[2][2][4][2], const pg8::Unit& u, int wr, int wc, int fr, int fq) const {
        const int h = u.pn - 6, chb = wc * 32 + 8 * fq, lane = fq * 16 + fr;
        float lbv[8];
        { const f32x4 a0 = *(const f32x4*)(a.hg_lb + h * 128 + chb), a1 = *(const f32x4*)(a.hg_lb + h * 128 + chb + 4), b0 = *(const f32x4*)(a.hg_lb + 512 + h * 128 + chb), b1 = *(const f32x4*)(a.hg_lb + 512 + h * 128 + chb + 4);
#pragma unroll
            for (int i = 0; i < 4; ++i) { lbv[i] = 1.0f / (1.0f + __expf(b0[i] - a0[i])); lbv[4 + i] = 1.0f / (1.0f + __expf(b1[i] - a1[i])); } }
#pragma unroll
        for (int ai = 0; ai < 2; ++ai) {
            const int rowc = u.pm * 256 + ai * 128 + wr * 64;
#pragma unroll
            for (int n = 0; n < 2; ++n) {
                float qt[4][4], kh[4][4], dtot[4];
#pragma unroll
                for (int i = 0; i < 4; ++i) {
                    const float lb = lbv[4 * n + i];
                    float sc[4], kf[4], rt[4];
#pragma unroll
                    for (int m = 0; m < 4; ++m) {
                        const float f = lb + (1.0f - lb) * sigmoidf_(acc[ai][1][m][n][i]);
                        kf[m] = 1.0f - f;
                        float s = __logf(f);
                        s += row_shr<1>(s); s += row_shr<2>(s); s += row_shr<4>(s); s += row_shr<8>(s);
                        sc[m] = s; rt[m] = row_last(s, lane);
                    }
                    const float tot = (rt[0] + rt[1]) + (rt[2] + rt[3]);
                    float off = 0.f;
#pragma unroll
                    for (int m = 0; m < 4; ++m) { const float b = sc[m] + off; off += rt[m];
                        qt[m][i] = acc[ai][0][m][n][i] * __expf(fminf(b - tot, 80.0f));
                        kh[m][i] = kf[m] * __expf(tot - b); }
                    dtot[i] = __expf(tot);
                }
#pragma unroll
                for (int m = 0; m < 4; ++m) { const int row = rowc + m * 16 + fr; bf16* dst = a.hg + ((size_t)((row >> 12) * 4 + h) * SEQ + (row & (SEQ - 1))) * 128 + chb + 4 * n;
                    v2u wq, wk; wq.x = pg8::cvt_pk_bf16(qt[m][0], qt[m][1]); wq.y = pg8::cvt_pk_bf16(qt[m][2], qt[m][3]); wk.x = pg8::cvt_pk_bf16(kh[m][0], kh[m][1]); wk.y = pg8::cvt_pk_bf16(kh[m][2], kh[m][3]);
                    *(v2u*)dst = wq; *(v2u*)(dst + (size_t)M * 512) = wk; }
                if (fr == 0) { float* dp = a.dch + ((size_t)(rowc >> 6) * 4 + h) * 128 + chb + 4 * n;
                    *(f32x4*)dp = (f32x4){dtot[0], dtot[1], dtot[2], dtot[3]}; }
            }
        }
    }
    DI void operator()(const pg8::f32x4 (&acc)[2][2][4][2], const pg8::Unit& u, int wr, int wc, int fr, int fq) const {
        const int row0 = u.pm * 256 + wr * 64 + fr;
        const int colt = u.pn * 256 + wc * 32 + 8 * fq;
        int kind = 0;
        if (MODE == 1) kind = (u.pn < 2) ? 0 : (u.pn < 6) ? 1 : (u.pn < 10) ? 5 : (u.pn < 12) ? 2 : (u.pn < 14) ? 3 : 4;
        if constexpr (MODE == 1) { if (kind == 5) { hgrn_tile(acc, u, wr, wc, fr, fq); return; } }
#pragma unroll
        for (int ai = 0; ai < 2; ++ai)
#pragma unroll
            for (int m = 0; m < 4; ++m) {
                const int row = row0 + ai * 128 + m * 16;
                if constexpr (MODE == 1) {
#pragma unroll
                    for (int bj = 0; bj < 2; ++bj) {
                        const int col = colt + bj * 128;
                        float v[8];
#pragma unroll
                        for (int i = 0; i < 4; ++i) { v[i] = acc[ai][bj][m][0][i]; v[4 + i] = acc[ai][bj][m][1][i]; }
                        bf16* dst;
                        const int bb = row >> 12, tt_ = row & (SEQ - 1);
                        if (kind <= 1) {
                            if (kind == 0) {
#pragma unroll
                                for (int i = 0; i < 8; ++i) v[i] *= QSCALE;
                            }
                            const int which = col >> 9, cw = col & 511;
                            dst = a.att + (size_t)which * ((size_t)M * 512) + ((size_t)(bb * 8 + (cw >> 6)) * SEQ + tt_) * 64 + (cw & 63);
                        } else if (kind == 2 || kind == 3) {
                            if (kind == 3) {
#pragma unroll
                                for (int i = 0; i < 8; ++i) v[i] = v[i] * sigmoidf_(v[i]);
                            }
                            const int cw = (col - 2560) & 511;
                            dst = a.hg + (size_t)kind * ((size_t)M * 512) + ((size_t)(bb * 4 + (cw >> 7)) * SEQ + tt_) * 128 + (cw & 127);
                        } else {
#pragma unroll
                            for (int i = 0; i < 8; ++i) v[i] = sigmoidf_(v[i]);
                            dst = a.g + (size_t)row * GW + (col - 3584);
                        }
                        ST16(dst, pack8(v));
                    }
                } else if constexpr (MODE == 2) {
#pragma unroll
                    for (int bj = 0; bj < 2; ++bj) {
                        const int col = colt + bj * 128;
                        float gb[8], v[8];
                        unpack8(*(const v4u*)(a.gate + (size_t)row * GW + 1024 + col), gb);
#pragma unroll
                        for (int i = 0; i < 4; ++i) { v[i] = fmaxf(gb[i], 1e-30f) * acc[ai][bj][m][0][i]; v[4 + i] = fmaxf(gb[4 + i], 1e-30f) * acc[ai][bj][m][1][i]; }
                        *(v4u*)(a.ob + (size_t)row * D + col) = pack8(v);
                    }
                } else if constexpr (MODE == 4 || MODE == 6 || MODE == 8) {
                    float r = 0.f;
                    if constexpr (MODE == 8) r = __builtin_amdgcn_rsqf(a.rs[row] * (1.0f / D) + EPS);
                    float s = 0.f;
#pragma unroll
                    for (int bj = 0; bj < 2; ++bj) {
                        const int col = colt + bj * 128;
                        const size_t off = (size_t)row * D + col;
                        float xr[8];
                        if constexpr (MODE == 4) { const f32x4 x0 = *(const f32x4*)(a.xres + off), x1 = *(const f32x4*)(a.xres + off + 4);
#pragma unroll
                            for (int i = 0; i < 4; ++i) { xr[i] = x0[i]; xr[4 + i] = x1[i]; } }
                        else unpack8(*(const v4u*)(a.xrb + off), xr);
                        float v[8];
#pragma unroll
                        for (int i = 0; i < 4; ++i) { v[i] = acc[ai][bj][m][0][i]; v[4 + i] = acc[ai][bj][m][1][i]; }
                        if constexpr (MODE == 8) {
                            float e[8]; unpack8(*(const v4u*)(a.gate + off), e);
#pragma unroll
                            for (int i = 0; i < 8; ++i) v[i] = e[i] * sigmoidf_(v[i] * r);
                        }
#pragma unroll
                        for (int i = 0; i < 8; ++i) { v[i] += xr[i]; s += v[i] * v[i]; }
                        *(v4u*)(a.ob + off) = pack8(v);
                    }
                    s += __shfl_xor(s, 16); s += __shfl_xor(s, 32);
                    if (fq == 0) atomicAdd(a.ss + row, s);
                } else if constexpr (MODE == 5) {
                    const float r = __builtin_amdgcn_rsqf(a.rs[row] * (1.0f / D) + EPS);
                    const int hcol = u.pn * 128 + wc * 32 + 8 * fq;
                    float v[8];
#pragma unroll
                    for (int i = 0; i < 4; ++i) {
                        const float g0 = acc[ai][0][m][0][i] * r, u0 = acc[ai][1][m][0][i] * r, g1 = acc[ai][0][m][1][i] * r, u1 = acc[ai][1][m][1][i] * r;
                        v[i] = g0 * sigmoidf_(g0) * u0; v[4 + i] = g1 * sigmoidf_(g1) * u1;
                    }
                    ST16(a.ob + (size_t)row * FF + hcol, pack8(v));
                } else {
#pragma unroll
                    for (int bj = 0; bj < 2; ++bj) {
                        const int col = colt + bj * 128;
                        float v[8];
#pragma unroll
                        for (int i = 0; i < 4; ++i) { v[i] = acc[ai][bj][m][0][i]; v[4 + i] = acc[ai][bj][m][1][i]; }
                        *(v4u*)(a.ob + (size_t)row * D + col) = pack8(v);
                    }
                }
            }
    }
};

DI float wave_sum(float v) {
#pragma unroll
    for (int o = 1; o < 64; o <<= 1) v += __shfl_xor(v, o);
    return v;
}
DI void p0_transpose_item(const float* W, int K, int N, const float* gain, bf16* WT, int GU, LAS float* scr, int item, int lane, int pitch = 0, int coff = 0) {
    if (pitch == 0) pitch = K;
    const int nblk = N / 32, kb = item / nblk, nb = item % nblk, k0 = 64 * kb, n0 = 32 * nb;
    int s0 = n0;
    if (GU == 1) { const int tile = n0 >> 8, j = n0 & 255; s0 = (j < 128) ? tile * 128 + j : FF + tile * 128 + (j - 128); }
    if (GU == 2) { const int tile = n0 >> 8, j = n0 & 255; if (tile >= 6 && tile < 10) s0 = (j < 128) ? 1536 + (tile - 6) * 128 + j : 2048 + (tile - 6) * 128 + (j - 128); }
    float wv[32];
#pragma unroll
    for (int i = 0; i < 32; ++i) wv[i] = W[(size_t)(k0 + 2 * i + (lane >> 5)) * N + s0 + (lane & 31)];
    if (gain) {
#pragma unroll
        for (int i = 0; i < 32; ++i) wv[i] *= gain[k0 + 2 * i + (lane >> 5)];
    }
#pragma unroll
    for (int i = 0; i < 32; ++i) scr[(2 * i + (lane >> 5)) * 33 + (lane & 31)] = wv[i];
    LDS_WAIT(); asm volatile("" ::: "memory");
    const int c = lane & 7;
#pragma unroll
    for (int j = 0; j < 4; ++j) { const int n = (lane >> 3) + 8 * j; const LAS float* s = scr + (8 * c) * 33 + n;
        v4u o; o.x = pg8::cvt_pk_bf16(s[0 * 33], s[1 * 33]); o.y = pg8::cvt_pk_bf16(s[2 * 33], s[3 * 33]); o.z = pg8::cvt_pk_bf16(s[4 * 33], s[5 * 33]); o.w = pg8::cvt_pk_bf16(s[6 * 33], s[7 * 33]);
        *(GAS v4u*)(WT + (size_t)(n0 + n) * pitch + coff + k0 + 8 * c) = o; }
    LDS_WAIT(); asm volatile("" ::: "memory");
}

struct Args { const float* in[16]; float* out; unsigned char* ws; };

typedef short s16x4 __attribute__((ext_vector_type(4)));
typedef float f32x16 __attribute__((ext_vector_type(16)));
typedef float f32x2_t __attribute__((ext_vector_type(2))); typedef __bf16 bf16x2_t __attribute__((ext_vector_type(2)));
typedef short v4i16_t __attribute__((ext_vector_type(4)));
DI unsigned cvtpk_s(float lo, float hi) { f32x2_t v = {lo, hi}; bf16x2_t b = __builtin_convertvector(v, bf16x2_t); return __builtin_bit_cast(unsigned, b); }
DI s16x4 vtr(const LAS unsigned char* p) { return __builtin_bit_cast(s16x4, __builtin_amdgcn_ds_read_tr16_b64_v4i16((LAS v4i16_t*)p)); }
DI int crow(int i, int hh) { return (i & 3) + 8 * (i >> 2) + 4 * hh; }
DI s16x4 vtr_asm(unsigned addr) { s16x4 r; asm volatile("ds_read_b64_tr_b16 %0, %1" : "=v"(r) : "v"(addr) : "memory"); return r; }
#define TR_WAIT4(a, b, c, d) do { asm volatile("s_waitcnt lgkmcnt(0)" : "+v"(a), "+v"(b), "+v"(c), "+v"(d) :: "memory"); __builtin_amdgcn_sched_barrier(0); } while (0)
DI pg8::bf16x8 pack_step(const f32x16& x, int s) {
    v4u p; p.x = cvtpk_s(x[8 * s], x[8 * s + 1]); p.y = cvtpk_s(x[8 * s + 2], x[8 * s + 3]); p.z = cvtpk_s(x[8 * s + 4], x[8 * s + 5]); p.w = cvtpk_s(x[8 * s + 6], x[8 * s + 7]);
    return __builtin_bit_cast(pg8::bf16x8, p);
}
#define MFMA32(a, b, c) __builtin_amdgcn_mfma_f32_32x32x16_bf16((a), (b), (c), 0, 0, 0)
#define HBAR() do { asm volatile("s_waitcnt lgkmcnt(0)" ::: "memory"); __builtin_amdgcn_s_barrier(); asm volatile("" ::: "memory"); } while (0)

#define MFMA16(a, b, c) __builtin_amdgcn_mfma_f32_16x16x32_bf16((a), (b), (c), 0, 0, 0)
struct A16Blk { int d, blk_start, res; };
DI A16Blk a16_blk(int s, int sp) {
    const int pass = s >> 4, bi = s & 15, d = (pass == 0) ? 16 : (pass == 1) ? 4 : 1, bpr = 16 / d;
    A16Blk B; B.d = d; B.res = bi / bpr; B.blk_start = sp * (2048 / d) + (bi % bpr) * 128; return B;
}
DI void a16_dma(LAS unsigned char* kbuf, LAS unsigned char* vbuf, LAS unsigned char* qbuf, const bf16* Qh, const bf16* Kh, const bf16* Vh, const A16Blk& B, int wave, int lane) {
#pragma unroll
    for (int i = 0; i < 4; ++i) {
        const int pc = wave * 4 + i, kk = pc * 8 + (lane >> 3);
        int l = B.blk_start - 128 + kk; if (l < 0) l = 0;
        const size_t rowi = (size_t)(l * B.d + B.res) * 64;
        const int ck = (lane & 7) ^ ((kk >> 1) & 7);
        const int cv = ((((lane & 7) >> 1) ^ ((kk >> 1) & 3)) << 1) + (lane & 1);
        __builtin_amdgcn_global_load_lds((const unsigned*)(Kh + rowi + ck * 8), (LAS unsigned*)(kbuf + pc * 1024), 16, 0, 0);
        __builtin_amdgcn_global_load_lds((const unsigned*)(Vh + rowi + cv * 8), (LAS unsigned*)(vbuf + pc * 1024), 16, 0, 0);
    }
#pragma unroll
    for (int i = 0; i < 2; ++i) {
        const int qr = i * 8 + (lane >> 3);
        const size_t rowq = (size_t)((B.blk_start + 16 * wave + qr) * B.d + B.res) * 64;
        __builtin_amdgcn_global_load_lds((const unsigned*)(Qh + rowq + (((lane & 7) ^ ((qr >> 1) & 7)) << 3)), (LAS unsigned*)(qbuf + i * 1024), 16, 0, 0);
    }
}
DI void attn16_unit(LAS unsigned char* lds, const bf16* ATT, bf16* Y, float* LSE, int b, int h, int sp, int tid) {
    const int lane = tid & 63, wave = __builtin_amdgcn_readfirstlane(tid >> 6);
    const int c = lane & 15, g = lane >> 4, tq4 = c >> 2, tp = c & 3;
    const bf16* Qh = ATT + (size_t)(b * 8 + h) * SEQ * 64; const bf16* Kh = Qh + (size_t)M * 512; const bf16* Vh = Kh + (size_t)M * 512;
    constexpr int NS = 48;
    { const A16Blk B0 = a16_blk(0, sp); a16_dma(lds, lds + 32768, lds + RING_BYTES + wave * 2048, Qh, Kh, Vh, B0, wave, lane); }
    VM_WAIT();
#pragma unroll 2
    for (int s = 0; s < NS; ++s) {
        const A16Blk B = a16_blk(s, sp);
        const int bs = s & 1, pass = s >> 4;
        LAS unsigned char* kb = lds + bs * 65536; LAS unsigned char* vb = kb + 32768;
        LAS unsigned char* qs = lds + RING_BYTES + bs * 16384 + wave * 2048;
        if (s == 16 || s == 32) {
            VM_WAIT(); HBAR();
            __builtin_amdgcn_fence(__ATOMIC_ACQUIRE, "agent");
            VM_WAIT();
        }
        asm volatile("s_waitcnt vmcnt(3)" ::: "memory"); HBAR();
        const size_t rowb = (size_t)b * SEQ + B.res;
        const int q0 = B.blk_start + 16 * wave;
        bf16* ybase = Y + rowb * 1024 + h * 64 + (lane & 7) * 8;
        const size_t tokc = rowb + (size_t)((q0 + c) * B.d);
        v4u prw0, prw1; float lp;
        if (pass > 0) {
            asm volatile("global_load_dwordx4 %0, %1, off" : "=v"(prw0) : "v"(ybase + (size_t)((q0 + (lane >> 3)) * B.d) * 1024) : "memory");
            asm volatile("global_load_dwordx4 %0, %1, off" : "=v"(prw1) : "v"(ybase + (size_t)((q0 + (lane >> 3) + 8) * B.d) * 1024) : "memory");
            asm volatile("global_load_dword %0, %1, off" : "=v"(lp) : "v"(LSE + tokc * 8 + h) : "memory");
        } else asm volatile("" : "=v"(prw0), "=v"(prw1), "=v"(lp));
        { const A16Blk Bn = a16_blk(s + 1 < NS ? s + 1 : s, sp);
            a16_dma(lds + (bs ^ 1) * 65536, lds + (bs ^ 1) * 65536 + 32768, lds + RING_BYTES + (bs ^ 1) * 16384 + wave * 2048, Qh, Kh, Vh, Bn, wave, lane); }
        pg8::bf16x8 qf[2];
#pragma unroll
        for (int sx = 0; sx < 2; ++sx) qf[sx] = *(const LAS pg8::bf16x8*)(qs + c * 128 + (((4 * sx + g) ^ ((c >> 1) & 7)) << 4));
        f32x4 S[10];
#pragma unroll
        for (int kt = 0; kt < 9; ++kt) {
            S[kt] = (f32x4){0.f, 0.f, 0.f, 0.f};
            const int key = 16 * wave + 16 * kt + c;
#pragma unroll
            for (int sx = 0; sx < 2; ++sx) {
                const pg8::bf16x8 kf = *(const LAS pg8::bf16x8*)(kb + key * 128 + (((4 * sx + g) ^ ((key >> 1) & 7)) << 4));
                S[kt] = MFMA16(kf, qf[sx], S[kt]);
            }
        }
        S[9] = (f32x4){0.f, 0.f, 0.f, 0.f};
        const float NEG = -1e30f;
#pragma unroll
        for (int i = 0; i < 4; ++i) { const int kr = 4 * g + i; S[0][i] = (kr >= c) ? S[0][i] : NEG; S[8][i] = (kr <= c) ? S[8][i] : NEG; }
        if (B.blk_start == 0) {
#pragma unroll
            for (int kt = 0; kt < 8; ++kt) if (wave + kt < 8) S[kt] = (f32x4){NEG, NEG, NEG, NEG};
        }
        float mx = NEG;
#pragma unroll
        for (int kt = 0; kt < 9; ++kt)
#pragma unroll
            for (int i = 0; i < 4; ++i) mx = fmaxf(mx, S[kt][i]);
        mx = fmaxf(mx, __shfl_xor(mx, 16)); mx = fmaxf(mx, __shfl_xor(mx, 32));
        float l = 0.f;
#pragma unroll
        for (int kt = 0; kt < 9; ++kt)
#pragma unroll
            for (int i = 0; i < 4; ++i) { const float pv = __builtin_amdgcn_exp2f(S[kt][i] - mx); S[kt][i] = pv; l += pv; }
        l += __shfl_xor(l, 16); l += __shfl_xor(l, 32);
        f32x4 O[4];
#pragma unroll
        for (int t = 0; t < 4; ++t) O[t] = (f32x4){0.f, 0.f, 0.f, 0.f};
#pragma unroll
        for (int j = 0; j < 5; ++j) {
            v4u pw; pw.x = cvtpk_s(S[2 * j][0], S[2 * j][1]); pw.y = cvtpk_s(S[2 * j][2], S[2 * j][3]); pw.z = cvtpk_s(S[2 * j + 1][0], S[2 * j + 1][1]); pw.w = cvtpk_s(S[2 * j + 1][2], S[2 * j + 1][3]);
            const pg8::bf16x8 pb = __builtin_bit_cast(pg8::bf16x8, pw);
            const int klo = 16 * wave + 32 * j + 4 * g + tq4, khi = (j < 4) ? klo + 16 : klo;
            const unsigned vb32 = (unsigned)(size_t)vb;
#define V16A(k_, t_) (vb32 + (k_) * 128 + (((t_) ^ (((k_) >> 1) & 3)) << 5) + 8 * tp)
            s16x4 l0 = vtr_asm(V16A(klo, 0)), h0 = vtr_asm(V16A(khi, 0)), l1 = vtr_asm(V16A(klo, 1)), h1 = vtr_asm(V16A(khi, 1));
            s16x4 l2 = vtr_asm(V16A(klo, 2)), h2 = vtr_asm(V16A(khi, 2)), l3 = vtr_asm(V16A(klo, 3)), h3 = vtr_asm(V16A(khi, 3));
#undef V16A
            asm volatile("s_waitcnt lgkmcnt(0)" : "+v"(l0), "+v"(h0), "+v"(l1), "+v"(h1), "+v"(l2), "+v"(h2), "+v"(l3), "+v"(h3) :: "memory"); __builtin_amdgcn_sched_barrier(0);
            O[0] = MFMA16(__builtin_shufflevector(l0, h0, 0, 1, 2, 3, 4, 5, 6, 7), pb, O[0]);
            O[1] = MFMA16(__builtin_shufflevector(l1, h1, 0, 1, 2, 3, 4, 5, 6, 7), pb, O[1]);
            O[2] = MFMA16(__builtin_shufflevector(l2, h2, 0, 1, 2, 3, 4, 5, 6, 7), pb, O[2]);
            O[3] = MFMA16(__builtin_shufflevector(l3, h3, 0, 1, 2, 3, 4, 5, 6, 7), pb, O[3]);
        }
        asm volatile("s_waitcnt vmcnt(10)" : "+v"(prw0), "+v"(prw1), "+v"(lp) :: "memory");
        float lse = mx + __builtin_amdgcn_logf(l);
        const float invl = 1.0f / l;
        const bool mrg = pass > 0;
        const float lpp = mrg ? lp : lse;
        const float mm = fmaxf(lpp, lse), ep = __builtin_amdgcn_exp2f(lpp - mm), en = __builtin_amdgcn_exp2f(lse - mm), inv = 1.0f / (ep + en);
        const float wp = ep * inv, wn = mrg ? en * inv * invl : invl;
        lse = mrg ? mm + __builtin_amdgcn_logf(ep + en) : lse;
        LDS_WAIT();
        { const int qr = (lane >> 3); *(LAS v4u*)(qs + qr * 128 + (((lane & 7) ^ (qr & 7)) << 4)) = prw0; *(LAS v4u*)(qs + (qr + 8) * 128 + (((lane & 7) ^ (qr & 7)) << 4)) = prw1; }
        LDS_WAIT();
#pragma unroll
        for (int t = 0; t < 4; ++t) {
            LAS unsigned char* ap = qs + c * 128 + (((2 * t + (g >> 1)) ^ (c & 7)) << 4) + 8 * (g & 1);
            const v2u pq = *(const LAS v2u*)ap;
            float o0 = O[t][0] * wn, o1 = O[t][1] * wn, o2 = O[t][2] * wn, o3 = O[t][3] * wn;
            const float m0 = o0 + wp * bflo(pq.x), m1 = o1 + wp * bfhi(pq.x), m2 = o2 + wp * bflo(pq.y), m3 = o3 + wp * bfhi(pq.y);
            o0 = mrg ? m0 : o0; o1 = mrg ? m1 : o1; o2 = mrg ? m2 : o2; o3 = mrg ? m3 : o3;
            v2u w; w.x = cvtpk_s(o0, o1); w.y = cvtpk_s(o2, o3);
            *(LAS v2u*)ap = w;
        }
        LDS_WAIT();
        v4u ow[2];
#pragma unroll
        for (int j = 0; j < 2; ++j) { const int qr = (lane >> 3) + 8 * j; ow[j] = *(const LAS v4u*)(qs + qr * 128 + (((lane & 7) ^ (qr & 7)) << 4)); }
#pragma unroll
        for (int j = 0; j < 2; ++j) *(v4u*)(ybase + (size_t)((q0 + (lane >> 3) + 8 * j) * B.d) * 1024) = ow[j];
        if (g == 0) LSE[tokc * 8 + h] = lse;
    }
    VM_WAIT(); HBAR();
}

constexpr int H_STAGE = 49152, H_QT = 0, H_KH = 16384, H_VV = 32768, H_ST = 98304, H_PSS = RING_BYTES + 1024;
DI int fsw(int s) { return ((s & 3) << 2) | ((s >> 2) & 3); }
DI pg8::bf16x8 rowfrag(const LAS unsigned char* base, int row, int ks, int hh) { return *(const LAS pg8::bf16x8*)(base + row * 256 + (((2 * ks + hh) ^ fsw(row)) << 4)); }

template <int NIMG> DI void hgrn_dma(LAS unsigned char* stg, const bf16* HG, size_t row0, int h, int wave, int lane) {
    const int t4 = lane >> 4, pc = lane & 15;
#pragma unroll
    for (int i = 0; i < 2 * NIMG; ++i) {
        const int p = wave * 2 * NIMG + i;
        const int img = p >> 4, pp = p & 15, t = pp * 4 + t4;
        const int im = (NIMG == 3) ? img : img + 1;
        int c;
        if (im < 2) c = pc ^ fsw(t); else c = (((pc >> 2) ^ (t & 3)) << 2) + (pc & 3);
        const bf16* src = HG + (size_t)im * ((size_t)M * 512) + ((size_t)((row0 >> 12) * 4 + h) * SEQ + (row0 & (SEQ - 1)) + t) * 128 + c * 8;
        __builtin_amdgcn_global_load_lds((const unsigned*)src, (LAS unsigned*)(stg + im * 16384 + pp * 1024), 16, 0, 0);
    }
}

DI void hgrn_vfrags(const LAS unsigned char* stg, pg8::bf16x8 (&vf)[2][2], int vt, int hh, int tq, int tp, int tblk) {
    const unsigned vb32 = (unsigned)(size_t)stg + H_VV;
    const int k0 = 4 * hh + tq;
#define HVA(k_) (vb32 + (k_) * 256 + ((vt ^ ((k_) & 3)) << 6) + 32 * tblk + 8 * tp)
    s16x4 a0 = vtr_asm(HVA(k0)), a1 = vtr_asm(HVA(k0 + 8)), a2 = vtr_asm(HVA(k0 + 16)), a3 = vtr_asm(HVA(k0 + 24));
    s16x4 a4 = vtr_asm(HVA(k0 + 32)), a5 = vtr_asm(HVA(k0 + 40)), a6 = vtr_asm(HVA(k0 + 48)), a7 = vtr_asm(HVA(k0 + 56));
#undef HVA
    asm volatile("s_waitcnt lgkmcnt(0)" : "+v"(a0), "+v"(a1), "+v"(a2), "+v"(a3), "+v"(a4), "+v"(a5), "+v"(a6), "+v"(a7) :: "memory"); __builtin_amdgcn_sched_barrier(0);
    vf[0][0] = __builtin_shufflevector(a0, a1, 0, 1, 2, 3, 4, 5, 6, 7); vf[0][1] = __builtin_shufflevector(a2, a3, 0, 1, 2, 3, 4, 5, 6, 7);
    vf[1][0] = __builtin_shufflevector(a4, a5, 0, 1, 2, 3, 4, 5, 6, 7); vf[1][1] = __builtin_shufflevector(a6, a7, 0, 1, 2, 3, 4, 5, 6, 7);
}
DI void hgrn_update(const LAS unsigned char* stg, f32x16 (&Sacc)[2], const pg8::bf16x8 (&vf)[2][2], int tt, int hh, int tq, int tp, int tblk) {
    const unsigned kb32 = (unsigned)(size_t)stg + H_KH;
    const int k0 = 4 * hh + tq;
#pragma unroll
    for (int j = 0; j < 2; ++j) {
        const int kt = 2 * tt + j, cch = 4 * kt + 2 * tblk + (tp >> 1);
#define HKA(k_) (kb32 + (k_) * 256 + ((cch ^ fsw(k_)) << 4) + 8 * (tp & 1))
#pragma unroll
        for (int st = 0; st < 2; ++st) {
            s16x4 a0 = vtr_asm(HKA(k0 + 32 * st)), a1 = vtr_asm(HKA(k0 + 32 * st + 8)), a2 = vtr_asm(HKA(k0 + 32 * st + 16)), a3 = vtr_asm(HKA(k0 + 32 * st + 24));
            TR_WAIT4(a0, a1, a2, a3);
            Sacc[j] = MFMA32(vf[st][0], __builtin_shufflevector(a0, a1, 0, 1, 2, 3, 4, 5, 6, 7), Sacc[j]);
            Sacc[j] = MFMA32(vf[st][1], __builtin_shufflevector(a2, a3, 0, 1, 2, 3, 4, 5, 6, 7), Sacc[j]);
        }
#undef HKA
    }
}

DI void hgrn_dmaA(LAS unsigned char* lds, int st, const bf16* HG, const float* DCH, size_t row0, int h, int wave, int lane) {
    hgrn_dma<2>(lds + st * 32768, HG, row0, h, wave, lane);
    if (wave < 2) __builtin_amdgcn_global_load_lds((const unsigned*)(DCH + ((row0 >> 6) * 4 + h) * 128 + wave * 64 + lane), (LAS unsigned*)(lds + 114688 + st * 512 + wave * 256), 4, 0, 0);
}
DI void hgrn_passA(LAS unsigned char* lds, const bf16* HG, const float* DCH, float* EST, float* DSEG, int bx, int G, int tid) {
    const int lane = tid & 63, wave = __builtin_amdgcn_readfirstlane(tid >> 6), vt = wave >> 1, tt = wave & 1;
    const int r = lane & 31, hh = lane >> 5, i16 = lane & 15, tq = i16 >> 2, tp = i16 & 3, tblk = (lane >> 4) & 1;
    const int nu = (bx < 1024) ? (1024 - bx + G - 1) / G : 0, nci = nu * 4;
    if (nci == 0) return;
    f32x16 Sacc[2]; float dprod[2] = {1.f, 1.f};
#define PA_ROW(ci_) ((size_t)(((bx + ((ci_) >> 2) * G) & 63) >> 2) * SEQ + ((bx + ((ci_) >> 2) * G) >> 6) * 256 + ((ci_) & 3) * 64)
#define PA_H(ci_) (((bx + ((ci_) >> 2) * G) & 63) & 3)
    hgrn_dmaA(lds, 0, HG, DCH, PA_ROW(0), PA_H(0), wave, lane);
    if (nci > 1) hgrn_dmaA(lds, 1, HG, DCH, PA_ROW(1), PA_H(1), wave, lane);
    if (nci > 1) { if (wave < 2) asm volatile("s_waitcnt vmcnt(5)" ::: "memory"); else asm volatile("s_waitcnt vmcnt(4)" ::: "memory"); } else VM_WAIT();
    HBAR();
    int st = 0;
    for (int ci = 0; ci < nci; ++ci) {
        const int u = bx + (ci >> 2) * G, c = ci & 3, bh = u & 63, seg = u >> 6, sid = bh * 16 + seg;
        LAS unsigned char* stg = lds + st * 32768;
        const LAS float* DV = (const LAS float*)(lds + 114688 + st * 512);
        const int st2 = (st == 0) ? 2 : st - 1;
        if (ci + 2 < nci) hgrn_dmaA(lds, st2, HG, DCH, PA_ROW(ci + 2), PA_H(ci + 2), wave, lane);
        if (c == 0) {
#pragma unroll
            for (int j = 0; j < 2; ++j) { dprod[j] = 1.f;
#pragma unroll
                for (int i = 0; i < 16; ++i) Sacc[j][i] = 0.f; }
        }
#pragma unroll
        for (int j = 0; j < 2; ++j) { const float dk = DV[32 * (2 * tt + j) + r]; dprod[j] *= dk;
#pragma unroll
            for (int i = 0; i < 16; ++i) Sacc[j][i] *= dk; }
        pg8::bf16x8 vf[2][2];
        hgrn_vfrags(stg, vf, vt, hh, tq, tp, tblk);
        hgrn_update(stg, Sacc, vf, tt, hh, tq, tp, tblk);
        if (c == 3) {
#pragma unroll
            for (int j = 0; j < 2; ++j)
#pragma unroll
                for (int i = 0; i < 16; ++i) EST[(size_t)sid * 16384 + (32 * vt + crow(i, hh)) * 128 + 32 * (2 * tt + j) + r] = Sacc[j][i];
            if (vt == 0 && hh == 0) { DSEG[sid * 128 + 64 * tt + r] = dprod[0]; DSEG[sid * 128 + 64 * tt + 32 + r] = dprod[1]; }
        }
        if (ci + 2 < nci) { if (wave < 2) asm volatile("s_waitcnt vmcnt(5)" ::: "memory"); else asm volatile("s_waitcnt vmcnt(4)" ::: "memory"); } else VM_WAIT();
        HBAR();
        st = (st == 2) ? 0 : st + 1;
    }
#undef PA_ROW
#undef PA_H
}
DI void hgrn_passB(float* EST, const float* DSEG, int bx, int G, int tid) {
    for (int w = bx; w < 256; w += G) {
        const int bh = w >> 2, e0 = (w & 3) * 4096 + tid * 8, k0 = e0 & 127;
        f32x4 s0 = {0.f, 0.f, 0.f, 0.f}, s1 = {0.f, 0.f, 0.f, 0.f};
#pragma unroll 5
        for (int seg = 1; seg < 16; ++seg) {
            const int sp = bh * 16 + seg - 1;
            const f32x4 d0 = *(const f32x4*)(DSEG + sp * 128 + k0), d1 = *(const f32x4*)(DSEG + sp * 128 + k0 + 4);
            const f32x4 x0 = *(const f32x4*)(EST + (size_t)sp * 16384 + e0), x1 = *(const f32x4*)(EST + (size_t)sp * 16384 + e0 + 4);
            s0 = d0 * s0 + x0; s1 = d1 * s1 + x1;
            *(f32x4*)(EST + (size_t)sp * 16384 + e0) = s0; *(f32x4*)(EST + (size_t)sp * 16384 + e0 + 4) = s1;
        }
    }
}
constexpr int H_OT = RING_BYTES + 4096;
DI void hgrn_passC(LAS unsigned char* lds, const bf16* HG, const float* DCH, const float* hg_norm, const float* SST, bf16* YB, int bx, int G, int tid) {
    const int lane = tid & 63, wave = __builtin_amdgcn_readfirstlane(tid >> 6), vt = wave >> 1, tt = wave & 1;
    const int r = lane & 31, hh = lane >> 5, i16 = lane & 15, tq = i16 >> 2, tp = i16 & 3, tblk = (lane >> 4) & 1;
    const int nu = (bx < 1024) ? (1024 - bx + G - 1) / G : 0, nci = nu * 4;
    if (nci == 0) return;
    f32x16 Sacc[2];
    if (tid < 128) ((LAS float*)(lds + H_PSS + 1024))[tid] = hg_norm[tid];
#define PC_U(ci_) (bx + ((ci_) >> 2) * G)
#define PC_ROW(ci_) ((size_t)((PC_U(ci_) & 63) >> 2) * SEQ + (PC_U(ci_) >> 6) * 256 + ((ci_) & 3) * 64)
#define PC_IMAGE(ci_) do { \
        const int u_ = PC_U(ci_), bh_ = u_ & 63, seg_ = u_ >> 6, sid_ = bh_ * 16 + seg_; \
        const float* dp_ = DCH + ((PC_ROW(ci_) >> 6) * 4 + (bh_ & 3)) * 128; \
        const float d0_ = dp_[64 * tt + r], d1_ = dp_[64 * tt + 32 + r]; \
        if (((ci_) & 3) == 0) { \
            _Pragma("unroll") for (int j = 0; j < 2; ++j) _Pragma("unroll") for (int i = 0; i < 16; ++i) \
                Sacc[j][i] = (seg_ > 0) ? SST[(size_t)(sid_ - 1) * 16384 + (32 * vt + crow(i, hh)) * 128 + 32 * (2 * tt + j) + r] : 0.f; } \
        _Pragma("unroll") for (int j = 0; j < 2; ++j) { const int kk = 32 * (2 * tt + j) + r; const float dk = j ? d1_ : d0_; \
            _Pragma("unroll") for (int i = 0; i < 16; ++i) { Sacc[j][i] *= dk; const int v = 32 * vt + crow(i, hh); \
                *(LAS bf16*)(lds + H_ST + v * 256 + (((kk >> 3) ^ fsw(v)) << 4) + (kk & 7) * 2) = (bf16)cvtpk_s(Sacc[j][i], 0.f); } } \
    } while (0)
    hgrn_dma<3>(lds, HG, PC_ROW(0), PC_U(0) & 3, wave, lane);
    PC_IMAGE(0);
    VM_WAIT(); HBAR();
    for (int ci = 0; ci < nci; ++ci) {
        const int u = PC_U(ci), c = ci & 3, h = u & 3;
        const size_t row0 = PC_ROW(ci);
        LAS unsigned char* stg = lds + (ci & 1) * H_STAGE;
        if (ci + 1 < nci) hgrn_dma<3>(lds + ((ci + 1) & 1) * H_STAGE, HG, PC_ROW(ci + 1), PC_U(ci + 1) & 3, wave, lane);
        const int nt_ = tid >> 3, nv0 = (tid & 7) * 16;
        const size_t nrow = row0 + nt_;
        const bf16* gp = HG + (size_t)3 * ((size_t)M * 512) + ((size_t)((nrow >> 12) * 4 + h) * SEQ + (nrow & (SEQ - 1))) * 128 + nv0;
        const v4u gq0 = *(const v4u*)gp, gq1 = *(const v4u*)(gp + 8);
        pg8::bf16x8 qb[8];
#pragma unroll
        for (int ks = 0; ks < 8; ++ks) qb[ks] = rowfrag(stg + H_QT, 32 * tt + r, ks, hh);
        pg8::bf16x8 vf[2][2];
        hgrn_vfrags(stg, vf, vt, hh, tq, tp, tblk);
        f32x16 O;
#pragma unroll
        for (int i = 0; i < 16; ++i) O[i] = 0.f;
#pragma unroll
        for (int ks = 0; ks < 8; ++ks) O = MFMA32(rowfrag(lds + H_ST, 32 * vt + r, ks, hh), qb[ks], O);
#pragma unroll
        for (int st = 0; st < 2; ++st) {
            if (st <= tt) {
                f32x16 X;
#pragma unroll
                for (int i = 0; i < 16; ++i) X[i] = 0.f;
#pragma unroll
                for (int ks = 0; ks < 8; ++ks) X = MFMA32(rowfrag(stg + H_KH, 32 * st + r, ks, hh), qb[ks], X);
                if (st == tt) {
#pragma unroll
                    for (int i = 0; i < 16; ++i) X[i] = (crow(i, hh) <= r) ? X[i] : 0.f;
                }
#pragma unroll
                for (int s_ = 0; s_ < 2; ++s_) O = MFMA32(vf[st][s_], pack_step(X, s_), O);
            }
        }
        if (c < 3) hgrn_update(stg, Sacc, vf, tt, hh, tq, tp, tblk);
        { float ss = 0.f;
#pragma unroll
            for (int i = 0; i < 16; ++i) ss += O[i] * O[i];
            ss += __shfl_xor(ss, 32);
            const int t = 32 * tt + r;
#pragma unroll
            for (int g4 = 0; g4 < 4; ++g4) { const int c8 = (32 * vt + 8 * g4 + 4 * hh) >> 2;
                v2u w; w.x = cvtpk_s(O[4 * g4], O[4 * g4 + 1]); w.y = cvtpk_s(O[4 * g4 + 2], O[4 * g4 + 3]);
                *(LAS v2u*)(lds + H_OT + t * 256 + ((c8 ^ (t & 31)) << 3)) = w; }
            if (hh == 0) ((LAS float*)(lds + H_PSS))[vt * 64 + t] = ss; }
        HBAR();
        { const int t = nt_, v0 = nv0;
            const LAS float* PSS = (const LAS float*)(lds + H_PSS);
            const float ss = (PSS[t] + PSS[64 + t]) + (PSS[128 + t] + PSS[192 + t]);
            const float rstd = __builtin_amdgcn_rsqf(ss * (1.0f / 128.0f) + EPS);
            bf16* yp = YB + nrow * 1024 + 512 + h * 128 + v0;
#pragma unroll
            for (int q8 = 0; q8 < 2; ++q8) {
                float gv[8], ov[8]; unpack8(q8 ? gq1 : gq0, gv);
                const int ca = (v0 + 8 * q8) >> 2;
                const v2u oa = *(const LAS v2u*)(lds + H_OT + t * 256 + ((ca ^ (t & 31)) << 3)), ob = *(const LAS v2u*)(lds + H_OT + t * 256 + (((ca + 1) ^ (t & 31)) << 3));
                const float of[8] = {bflo(oa.x), bfhi(oa.x), bflo(oa.y), bfhi(oa.y), bflo(ob.x), bfhi(ob.x), bflo(ob.y), bfhi(ob.y)};
                const f32x4 na = *(const LAS f32x4*)(lds + H_PSS + 1024 + (v0 + 8 * q8) * 4), nb = *(const LAS f32x4*)(lds + H_PSS + 1024 + (v0 + 8 * q8 + 4) * 4);
#pragma unroll
                for (int i = 0; i < 4; ++i) { ov[i] = of[i] * rstd * na[i] * gv[i]; ov[4 + i] = of[4 + i] * rstd * nb[i] * gv[4 + i]; }
                *(v4u*)(yp + 8 * q8) = pack8(ov);
            }
        }
        if (ci + 1 < nci) PC_IMAGE(ci + 1);
        VM_WAIT(); HBAR();
    }
#undef PC_IMAGE
#undef PC_ROW
#undef PC_U
}

__global__ void __launch_bounds__(NTHR, 2) fwd_kernel(Args args) {
    extern __shared__ __attribute__((aligned(16))) unsigned char lds_raw[];
    LAS unsigned char* lds = (LAS unsigned char*)lds_raw;
    volatile LAS unsigned* MISC = (volatile LAS unsigned*)(lds + MISC_OFF);
    const int tid = threadIdx.x, lane = tid & 63, wave = __builtin_amdgcn_readfirstlane(tid >> 6);
    const int G = gridDim.x, bx = blockIdx.x;
    unsigned char* ws = args.ws;
    gu32* ctl = (gu32*)(ws + WS_CTL);
    const float* x = args.in[0]; const float* p = args.in[1]; const float* norm_mix = args.in[2]; const float* w_in = args.in[3]; const float* hg_lb = args.in[4]; const float* hg_norm = args.in[5];
    const float* w_a_up = args.in[6]; const float* w_b_up = args.in[7]; const float* w_out = args.in[8]; const float* norm_ffn = args.in[9]; const float* w_gu = args.in[10]; const float* w_down = args.in[11];
    const float* norm_ple = args.in[12]; const float* w_pe = args.in[13]; const float* w_pg = args.in[14]; const float* norm_final = args.in[15];
    float* out = args.out;
    bf16* WIN = (bf16*)(ws + WS_WIN); bf16* WGU = (bf16*)(ws + WS_WGU); bf16* WDN = (bf16*)(ws + WS_WDN); bf16* WOUT = (bf16*)(ws + WS_WOUT); bf16* WPG = (bf16*)(ws + WS_WPG);
    bf16* WA = (bf16*)(ws + WS_WA); bf16* WB = (bf16*)(ws + WS_WB); bf16* WPE = (bf16*)(ws + WS_WPE);
    bf16* PB = (bf16*)(ws + WS_PB); bf16* XB = (bf16*)(ws + WS_XB); bf16* YA = (bf16*)(ws + WS_YA); bf16* YB = (bf16*)(ws + WS_YB);
    bf16* ATT = (bf16*)(ws + WS_ATT); bf16* HG = (bf16*)(ws + WS_HG); bf16* GT = (bf16*)(ws + WS_GT);
    float* LSEB = (float*)(ws + WS_LSE);
    float* EST = (float*)(ws + WS_EST); float* DSEG = (float*)(ws + WS_DSEG);
    float* DCH = (float*)(ws + WS_DCH);
    bf16* MRG = ATT; bf16* X1B = HG; bf16* HID = GT; bf16* X2B = ATT; bf16* PE = XB; bf16* X3B = HG;
    float* SS1 = (float*)(ctl + CW_SS1); float* SS2 = (float*)(ctl + CW_SS2); float* SS3 = (float*)(ctl + CW_SS3);

    for (int u = tid; u < (LDS_BYTES - LDSCTL_OFF) / 4; u += NTHR) ((LAS unsigned*)(lds + LDSCTL_OFF))[u] = 0u;
    __syncthreads();
    XcdBarrier bar = xcd_barrier_post((unsigned*)(ctl + CW_BAR), MISC + 8);

    {
        LAS float* scr = (LAS float*)(lds + RING_OFF + wave * 16384);
        const int gw = bx * NWAVES + wave, NGW = G * NWAVES;
        constexpr int I_IN = (D / 64) * (NIN / 32), I_GU = I_IN, I_DN = (FF / 64) * (D / 32), I_SQ = (D / 64) * (D / 32), I_AB = (512 / 64) * (D / 32), I_PE = (PLE / 64) * (D / 32);
        constexpr int NITEMS = I_IN + I_GU + I_DN + 2 * I_SQ + 2 * I_AB + I_PE;
        for (int it = gw; it < NITEMS; it += NGW) {
            int r = it;
            if (r < I_IN) { p0_transpose_item(w_in, D, NIN, norm_mix, WIN, 2, scr, r, lane); continue; } r -= I_IN;
            if (r < I_GU) { p0_transpose_item(w_gu, D, NIN, norm_ffn, WGU, 1, scr, r, lane); continue; } r -= I_GU;
            if (r < I_DN) { p0_transpose_item(w_down, FF, D, nullptr, WDN, 0, scr, r, lane); continue; } r -= I_DN;
            if (r < I_SQ) { p0_transpose_item(w_out, D, D, nullptr, WOUT, 0, scr, r, lane); continue; } r -= I_SQ;
            if (r < I_SQ) { p0_transpose_item(w_pg, D, D, norm_ple, WPG, 0, scr, r, lane); continue; } r -= I_SQ;
            if (r < I_AB) { p0_transpose_item(w_a_up, 512, D, nullptr, WA, 0, scr, r, lane, 1024, 0); continue; } r -= I_AB;
            if (r < I_AB) { p0_transpose_item(w_b_up, 512, D, nullptr, WA, 0, scr, r, lane, 1024, 512); continue; } r -= I_AB;
            p0_transpose_item(w_pe, PLE, D, nullptr, WPE, 0, scr, r, lane);
        }
        for (int m0 = 4 * gw; m0 < M; m0 += 4 * NGW) {
            f32x4 v[4][4], pv[4];
#pragma unroll
            for (int rr = 0; rr < 4; ++rr) {
                const GAS f32x4* xr = (const GAS f32x4*)(x + (size_t)(m0 + rr) * D) + lane;
#pragma unroll
                for (int j = 0; j < 4; ++j) v[rr][j] = xr[64 * j];
                pv[rr] = ((const GAS f32x4*)(p + (size_t)(m0 + rr) * PLE))[lane];
            }
#pragma unroll
            for (int rr = 0; rr < 4; ++rr) {
                float s = 0.f;
#pragma unroll
                for (int j = 0; j < 4; ++j) s += (v[rr][j].x * v[rr][j].x + v[rr][j].y * v[rr][j].y) + (v[rr][j].z * v[rr][j].z + v[rr][j].w * v[rr][j].w);
                s = wave_sum(s);
                const float rs = __builtin_amdgcn_rsqf(s * (1.0f / D) + EPS);
                GAS v2u* o8 = (GAS v2u*)(XB + (size_t)(m0 + rr) * D) + lane;
#pragma unroll
                for (int j = 0; j < 4; ++j) { v2u w; w.x = pg8::cvt_pk_bf16(v[rr][j].x * rs, v[rr][j].y * rs); w.y = pg8::cvt_pk_bf16(v[rr][j].z * rs, v[rr][j].w * rs); o8[64 * j] = w; }
                v2u w; w.x = pg8::cvt_pk_bf16(pv[rr].x, pv[rr].y); w.y = pg8::cvt_pk_bf16(pv[rr].z, pv[rr].w);
                ((GAS v2u*)(PB + (size_t)(m0 + rr) * PLE))[lane] = w;
            }
        }
    }
    xcd_barrier(bar);

    {
        pg8::Gemm g{XB, WIN, M, NIN, D}; pg8::StaticOrder S; S.init(M, NIN, G, bx);
        Epi<1> E{}; E.a.att = ATT; E.a.hg = HG; E.a.g = GT; E.a.hg_lb = hg_lb; E.a.dch = DCH;
        pg8::gemm_phase<Epi<1>, pg8::StaticOrder, true, true>(lds + RING_OFF, g, S, E);
    }
    xcd_barrier(bar);

#define HG_ALL() do { hgrn_passA(lds, HG, DCH, EST, DSEG, bx, G, tid); xcd_barrier(bar); hgrn_passB(EST, DSEG, bx, G, tid); xcd_barrier(bar); \
    hgrn_passC(lds, HG, DCH, hg_norm, EST, YB, bx, G, tid); } while (0)
    HG_ALL();
    for (int u = bx; u < 256; u += G) attn16_unit(lds + RING_OFF, ATT, YA, LSEB, u >> 4, (u >> 1) & 7, u & 1, tid);
    __syncthreads();
    for (int u = tid; u < (LDS_BYTES - LDSCTL_OFF) / 4; u += NTHR) ((LAS unsigned*)(lds + LDSCTL_OFF))[u] = 0u;
    __syncthreads();
    xcd_barrier(bar);

    {
        pg8::SplitOrder S; S.init(M, D, G, bx);
        pg8::Gemm g{YA, WA, M, D, 512, 1024}; Epi<2> E{}; E.a.gate = GT; E.a.ob = MRG;
        pg8::gemm_phase<Epi<2>, pg8::SplitOrder, true, true>(lds + RING_OFF, g, S, E);
    }
    xcd_barrier(bar);

    {
        pg8::Gemm g{MRG, WOUT, M, D, D}; pg8::StaticOrder S; S.init(M, D, G, bx);
        Epi<4> E{}; E.a.xres = x; E.a.ob = X1B; E.a.ss = SS1;
        pg8::gemm_phase<Epi<4>, pg8::StaticOrder, true, true>(lds + RING_OFF, g, S, E);
    }
    xcd_barrier(bar);

    {
        pg8::Gemm g{X1B, WGU, M, NIN, D}; pg8::StaticOrder S; S.init(M, NIN, G, bx);
        Epi<5> E{}; E.a.rs = SS1; E.a.ob = HID;
        pg8::gemm_phase<Epi<5>, pg8::StaticOrder, true, true>(lds + RING_OFF, g, S, E);
    }
    xcd_barrier(bar);

    {
        pg8::Gemm g{HID, WDN, M, D, FF}; pg8::StaticOrder S; S.init(M, D, G, bx);
        Epi<6> E{}; E.a.xrb = X1B; E.a.ob = X2B; E.a.ss = SS2;
        pg8::gemm_phase<Epi<6>, pg8::StaticOrder, true, true>(lds + RING_OFF, g, S, E);
    }
    xcd_barrier(bar);

    {
        pg8::StaticOrder S; S.init(M, D, G, bx);
        { pg8::Gemm g{PB, WPE, M, D, PLE}; Epi<7> E{}; E.a.ob = PE; pg8::gemm_phase<Epi<7>, pg8::StaticOrder, true, true>(lds + RING_OFF, g, S, E); }
        { pg8::Gemm g{X2B, WPG, M, D, D}; Epi<8> E{}; E.a.rs = SS2; E.a.gate = PE; E.a.xrb = X2B; E.a.ob = X3B; E.a.ss = SS3; pg8::gemm_phase<Epi<8>, pg8::StaticOrder, true, true>(lds + RING_OFF, g, S, E); }
    }
    xcd_barrier(bar);

    {
        const int gw = bx * NWAVES + wave, NGW = G * NWAVES;
        const bool bad = __hip_atomic_load(ctl + CW_BAR + XB_TMO, RLX_AGENT) != 0u;
        for (int m0 = 4 * gw; m0 < M; m0 += 4 * NGW) {
            v4u xin[4][2]; float rr_[4];
#pragma unroll
            for (int q = 0; q < 4; ++q) { const v4u* xr = (const v4u*)(X3B + (size_t)(m0 + q) * D) + lane; xin[q][0] = xr[0]; xin[q][1] = xr[64]; rr_[q] = SS3[m0 + q]; }
#pragma unroll
            for (int q = 0; q < 4; ++q) {
                float r = __builtin_amdgcn_rsqf(rr_[q] * (1.0f / D) + EPS);
                if (bad) r = __builtin_nanf("");
                f32x4* orow = (f32x4*)(out + (size_t)(m0 + q) * D);
#pragma unroll
                for (int j = 0; j < 2; ++j) {
                    float v[8]; unpack8(xin[q][j], v);
                    const int c0 = 512 * j + 8 * lane;
                    const f32x4 g0 = *(const f32x4*)(norm_final + c0), g1 = *(const f32x4*)(norm_final + c0 + 4);
                    orow[(c0 >> 2)] = (f32x4){v[0] * r * g0[0], v[1] * r * g0[1], v[2] * r * g0[2], v[3] * r * g0[3]};
                    orow[(c0 >> 2) + 1] = (f32x4){v[4] * r * g1[0], v[5] * r * g1[1], v[6] * r * g1[2], v[7] * r * g1[3]};
                }
            }
        }
    }
}

extern "C" void kernel_launch(void* const* d_in, const int* in_sizes, int n_in, void* d_out, int out_size, void* d_ws, size_t ws_size, hipStream_t stream) {
    static int grid = 0;
    if (grid == 0) {
        if (n_in != 16 || out_size != M * D || ws_size < WS_END) { fprintf(stderr, "kernel_launch: unexpected shapes (n_in %d out %d ws %zu)\n", n_in, out_size, ws_size); grid = -1; return; }
        int dev = 0, cus = 0, per_cu = 0;
        if (hipGetDevice(&dev) != hipSuccess || hipDeviceGetAttribute(&cus, hipDeviceAttributeMultiprocessorCount, dev) != hipSuccess) { grid = -1; return; }
        if (hipFuncSetAttribute((const void*)fwd_kernel, hipFuncAttributeMaxDynamicSharedMemorySize, LDS_BYTES) != hipSuccess) { fprintf(stderr, "kernel_launch: hipFuncSetAttribute failed\n"); grid = -1; return; }
        if (hipOccupancyMaxActiveBlocksPerMultiprocessor(&per_cu, (const void*)fwd_kernel, NTHR, LDS_BYTES) != hipSuccess || per_cu < 1) fprintf(stderr, "kernel_launch: occupancy query says %d\n", per_cu);
        (void)hipGetLastError();
        grid = cus;
    }
    if (grid < 0) return;
    (void)hipMemsetAsync((char*)d_ws + WS_CTL, 0, CTL_ZERO_BYTES, stream);
    Args a{};
    for (int i = 0; i < 16; ++i) a.in[i] = (const float*)d_in[i];
    a.out = (float*)d_out; a.ws = (unsigned char*)d_ws;
    hipLaunchKernelGGL(fwd_kernel, dim3(grid), dim3(NTHR), LDS_BYTES, stream, a);
}
```

```cpp
#include <hip/hip_runtime.h>
#include <cstdio>
#include <cstdint>
namespace pg8 {
#define PG8_LAS __attribute__((address_space(3)))
typedef unsigned short bf16_t;
typedef short bf16x8 __attribute__((ext_vector_type(8)));
typedef float f32x4 __attribute__((ext_vector_type(4)));
typedef unsigned u32x4 __attribute__((ext_vector_type(4)));
constexpr int BM = 256, BK = 64, HALF = 128, HTB = HALF * BK * 2  , STAGE_BYTES = 8 * HTB, NXCD = 8, WGM = 4;

__host__ __device__ __forceinline__ int lds_byte(int r, int c) { const int st = (r >> 4) * 2 + (c >> 5), rr = r & 15, cc = c & 31, ob = rr * 64 + cc * 2; return st * 1024 + (ob ^ (((ob >> 9) & 1) << 5)); }
__host__ __device__ __forceinline__ void stage_rc(int b, int& R, int& C) { const int st = b / 1024, sb = b % 1024, swz = sb ^ (((sb >> 9) & 1) << 5); R = (st >> 1) * 16 + swz / 64; C = (st & 1) * 32 + (swz % 64) / 2; }
__host__ __device__ __forceinline__ int perm32(int rho) { const int n = rho >> 4, i = rho & 15; return 8 * (i >> 2) + 4 * n + (i & 3); }

struct Unit { int pm, pn, ks; };
struct Gemm { const bf16_t* A; const bf16_t* Bt; int M, N, K, ld; };

struct StaticOrder {
    int nM, nN, nwg, G, c;
    __host__ __device__ void init(int M, int N, int G_, int c_) { nM = M / BM; nN = N / BM; nwg = nM * nN; G = G_; c = c_; }
    __host__ __device__ bool next(int i, Unit& u) const {
        const long L = (long)i * G + c; if (L >= nwg) return false;
        int wgid = (int)L; { const int q = nwg / NXCD, r = nwg % NXCD, xcd = wgid % NXCD, off = wgid / NXCD; wgid = (xcd < r ? xcd * (q + 1) : r * (q + 1) + (xcd - r) * q) + off; }
        const int nig = WGM * nN, gid = wgid / nig, fm = gid * WGM, gsz = (nM - fm) < WGM ? (nM - fm) : WGM;
        u.pm = fm + ((wgid % nig) % gsz); u.pn = (wgid % nig) / gsz; u.ks = 0; return true;
    }
    __device__ __forceinline__ void a_ready(const Unit&) const {}
    __device__ __forceinline__ void done(const Unit&) const {}
};
struct SplitOrder : StaticOrder {
    __host__ __device__ bool next(int i, Unit& u) const { if (!StaticOrder::next(i >> 1, u)) return false; u.ks = i & 1; return true; }
};

__device__ __forceinline__ unsigned cvt_pk_bf16(float lo, float hi) { unsigned r; asm volatile("v_cvt_pk_bf16_f32 %0, %1, %2" : "=v"(r) : "v"(lo), "v"(hi)); return r; }
template <class Epi, class Sched, bool ALIGN_EPI = false, bool SP2 = false>
__device__ __forceinline__ void gemm_phase(PG8_LAS unsigned char* lds, const Gemm g, const Sched& S, const Epi& E) {
    int tid_ = threadIdx.x; asm volatile("" : "+v"(tid_));
    const int tid = tid_, wid = __builtin_amdgcn_readfirstlane(tid >> 6), lane = tid & 63, wr = wid >> 2, wc = wid & 3, fr = lane & 15, fq = lane >> 4;
    const int K = g.K, nt = K / BK, ld = g.ld ? g.ld : K;
    unsigned voffA[2], voffB[2];
#pragma unroll
    for (int i = 0; i < 2; ++i) { int R, C; stage_rc(tid * 16 + i * 8192, R, C); const int Rb = Epi::PERM ? ((R & ~31) + perm32(R & 31)) : R;
        voffA[i] = (unsigned)(R * ld + C) * 2u; voffB[i] = (unsigned)(Rb * ld + C) * 2u; }
    const size_t kstep = (size_t)(BK * 2);
    const size_t hstep = (size_t)HALF * ld * 2;
    const size_t tstep = 2 * hstep;
    const unsigned ldsw = (unsigned)wid * 1024u;
    const int aoff = lds_byte(wr * 64 + fr, fq * 8), boff = lds_byte(wc * 32 + fr, fq * 8);
#define PG8_SA(b, h) (((b) * 2 + (h)) * HTB)
#define PG8_SB(b, h) ((4 + (b) * 2 + (h)) * HTB)
#define PG8_STAGE(bufoff, gbase, voff) do { _Pragma("unroll") for (int _i = 0; _i < 2; ++_i) \
        __builtin_amdgcn_global_load_lds((const unsigned*)((const char*)(gbase) + (voff)[_i]), (PG8_LAS unsigned*)(lds + (bufoff) + ldsw + _i * 8192), 16, 0, 0); } while (0)
#define PG8_LDA(dst, b, h) do { _Pragma("unroll") for (int m = 0; m < 4; ++m) _Pragma("unroll") for (int k = 0; k < 2; ++k) dst[m][k] = *(const PG8_LAS bf16x8*)(lds + PG8_SA(b, h) + aoff + m * 2048 + k * 1024); } while (0)
#define PG8_LDB(dst, b, h) do { _Pragma("unroll") for (int n = 0; n < 2; ++n) _Pragma("unroll") for (int k = 0; k < 2; ++k) dst[n][k] = *(const PG8_LAS bf16x8*)(lds + PG8_SB(b, h) + boff + n * 2048 + k * 1024); } while (0)
#define PG8_MMA(ai, bj, At, Bt) do { __builtin_amdgcn_s_setprio(1); _Pragma("unroll") for (int m = 0; m < 4; ++m) _Pragma("unroll") for (int n = 0; n < 2; ++n) _Pragma("unroll") for (int k = 0; k < 2; ++k) \
        acc[ai][bj][m][n] = __builtin_amdgcn_mfma_f32_16x16x32_bf16(Bt[n][k], At[m][k], acc[ai][bj][m][n], 0, 0, 0); __builtin_amdgcn_s_setprio(0); } while (0)
#define PG8_WAIT_V(n) asm volatile("s_waitcnt vmcnt(" #n ")" ::: "memory")
#define PG8_WAIT_L(n) asm volatile("s_waitcnt lgkmcnt(" #n ")" ::: "memory")
#define PG8_BAR __builtin_amdgcn_s_barrier()
#define PG8_SCHED __builtin_amdgcn_sched_barrier(0)
    Unit cur, nxt; int ui = 0;
    if (!S.next(0, cur)) return;
    f32x4 acc[2][2][4][2];
#pragma unroll
    for (int a = 0; a < 2; ++a)
#pragma unroll
        for (int b = 0; b < 2; ++b)
#pragma unroll
            for (int m = 0; m < 4; ++m)
#pragma unroll
                for (int n = 0; n < 2; ++n) acc[a][b][m][n] = (f32x4){0.f, 0.f, 0.f, 0.f};
    bf16x8 At[4][2], B0[2][2], B1[2][2];
    const char* cA = (const char*)g.A + (size_t)cur.pm * tstep + (size_t)cur.ks * K * 2; const char* cB = (const char*)g.Bt + (size_t)cur.pn * tstep + (size_t)cur.ks * K * 2;
    S.a_ready(cur);
    if constexpr (SP2) {
        PG8_STAGE(PG8_SB(0, 0), cB, voffB); PG8_STAGE(PG8_SB(0, 1), cB + hstep, voffB); PG8_STAGE(PG8_SA(0, 0), cA, voffA); PG8_STAGE(PG8_SA(0, 1), cA + hstep, voffA);
        if (wr == 1) PG8_BAR;
        PG8_WAIT_V(2); PG8_BAR;
        PG8_STAGE(PG8_SB(1, 0), cB + kstep, voffB); PG8_STAGE(PG8_SA(1, 0), cA + kstep, voffA); PG8_STAGE(PG8_SB(1, 1), cB + hstep + kstep, voffB);
        PG8_WAIT_V(6); PG8_BAR;
    } else {
        PG8_STAGE(PG8_SB(0, 0), cB, voffB); PG8_STAGE(PG8_SA(0, 0), cA, voffA); PG8_STAGE(PG8_SB(0, 1), cB + hstep, voffB); PG8_STAGE(PG8_SA(0, 1), cA + hstep, voffA);
        if (wr == 1) PG8_BAR;
        PG8_WAIT_V(4); PG8_BAR;
        PG8_STAGE(PG8_SB(1, 0), cB + kstep, voffB); PG8_STAGE(PG8_SA(1, 0), cA + kstep, voffA); PG8_STAGE(PG8_SB(1, 1), cB + hstep + kstep, voffB);
        PG8_WAIT_V(6); PG8_BAR;
    }
    for (;;) {
        const bool has_next = S.next(ui + 1, nxt);
        const char* nA = has_next ? (const char*)g.A + (size_t)nxt.pm * tstep + (size_t)nxt.ks * K * 2 : cA; const char* nB = has_next ? (const char*)g.Bt + (size_t)nxt.pn * tstep + (size_t)nxt.ks * K * 2 : cB;
#pragma nounroll
        for (int t = 0; t < nt; t += 2) {
            const bool last = (t == nt - 2);
            const char* a1 = cA + (size_t)(t + 1) * kstep;
            const char* a2 = last ? nA : cA + (size_t)(t + 2) * kstep; const char* b2 = last ? nB : cB + (size_t)(t + 2) * kstep;
            const char* a3 = a2 + kstep; const char* b3 = b2 + kstep;
            if (last && has_next) S.a_ready(nxt);
            if constexpr (SP2) {
            PG8_LDB(B0, 0, 0); PG8_LDB(B1, 0, 1); PG8_SCHED; PG8_LDA(At, 0, 0); PG8_STAGE(PG8_SA(1, 1), a1 + hstep, voffA);
            PG8_WAIT_V(8); PG8_WAIT_L(0); PG8_BAR; PG8_MMA(0, 0, At, B0); PG8_MMA(0, 1, At, B1); PG8_BAR; PG8_SCHED;
            PG8_LDA(At, 0, 1); PG8_STAGE(PG8_SB(0, 0), b2, voffB); PG8_STAGE(PG8_SB(0, 1), b2 + hstep, voffB); PG8_STAGE(PG8_SA(0, 0), a2, voffA);
            PG8_WAIT_V(8); PG8_WAIT_L(0); PG8_BAR; PG8_MMA(1, 0, At, B0); PG8_MMA(1, 1, At, B1); PG8_BAR; PG8_SCHED;
            PG8_LDB(B0, 1, 0); PG8_LDB(B1, 1, 1); PG8_SCHED; PG8_LDA(At, 1, 0); PG8_STAGE(PG8_SA(0, 1), a2 + hstep, voffA);
            PG8_WAIT_V(8); PG8_WAIT_L(0); PG8_BAR; PG8_MMA(0, 0, At, B0); PG8_MMA(0, 1, At, B1); PG8_BAR; PG8_SCHED;
            PG8_LDA(At, 1, 1); PG8_STAGE(PG8_SB(1, 0), b3, voffB); PG8_STAGE(PG8_SB(1, 1), b3 + hstep, voffB); PG8_STAGE(PG8_SA(1, 0), a3, voffA);
            PG8_WAIT_V(8); PG8_WAIT_L(0); PG8_BAR; PG8_MMA(1, 0, At, B0); PG8_MMA(1, 1, At, B1); PG8_BAR; PG8_SCHED;
            } else {
            PG8_LDB(B0, 0, 0); PG8_SCHED; PG8_LDA(At, 0, 0); PG8_STAGE(PG8_SA(1, 1), a1 + hstep, voffA);
            PG8_WAIT_L(8); PG8_BAR; PG8_WAIT_L(0); PG8_MMA(0, 0, At, B0); PG8_BAR; PG8_SCHED;
            PG8_LDB(B1, 0, 1); PG8_STAGE(PG8_SB(0, 0), b2, voffB);
            PG8_BAR; PG8_WAIT_L(0); PG8_MMA(0, 1, At, B1); PG8_BAR;
            PG8_LDA(At, 0, 1); PG8_STAGE(PG8_SA(0, 0), a2, voffA);
            PG8_BAR; PG8_WAIT_L(0); PG8_MMA(1, 0, At, B0); PG8_BAR; PG8_SCHED;
            PG8_STAGE(PG8_SB(0, 1), b2 + hstep, voffB);
            PG8_WAIT_V(6); PG8_BAR; PG8_MMA(1, 1, At, B1); PG8_BAR;
            PG8_LDB(B0, 1, 0); PG8_SCHED; PG8_LDA(At, 1, 0); PG8_STAGE(PG8_SA(0, 1), a2 + hstep, voffA);
            PG8_WAIT_L(8); PG8_BAR; PG8_WAIT_L(0); PG8_MMA(0, 0, At, B0); PG8_BAR; PG8_SCHED;
            PG8_LDB(B1, 1, 1); PG8_STAGE(PG8_SB(1, 0), b3, voffB);
            PG8_BAR; PG8_WAIT_L(0); PG8_MMA(0, 1, At, B1); PG8_BAR;
            PG8_LDA(At, 1, 1); PG8_STAGE(PG8_SA(1, 0), a3, voffA);
            PG8_BAR; PG8_WAIT_L(0); PG8_MMA(1, 0, At, B0); PG8_BAR; PG8_SCHED;
            PG8_STAGE(PG8_SB(1, 1), b3 + hstep, voffB);
            PG8_WAIT_V(6); PG8_BAR; PG8_MMA(1, 1, At, B1); PG8_BAR;
            }
        }
        if constexpr (ALIGN_EPI) { if (wr == 0) PG8_BAR; }
        bool keep_acc = false;
        if constexpr (Epi::KSPLIT) { if (cur.ks == 0) { E.mid(acc, cur, wr, wc, fr, fq); keep_acc = true; } }
        if constexpr (!Epi::AFTER_DRAIN) { if (!keep_acc) { E(acc, cur, wr, wc, fr, fq); S.done(cur); } }
        if (!has_next) break;
        if (!keep_acc)
#pragma unroll
        for (int a = 0; a < 2; ++a)
#pragma unroll
            for (int b = 0; b < 2; ++b)
#pragma unroll
                for (int m = 0; m < 4; ++m)
#pragma unroll
                    for (int n = 0; n < 2; ++n) acc[a][b][m][n] = (f32x4){0.f, 0.f, 0.f, 0.f};
        cur = nxt; cA = nA; cB = nB; ++ui;
        if constexpr (ALIGN_EPI) { if (wr == 1) PG8_BAR; }
    }
    PG8_WAIT_V(0);
    if constexpr (!ALIGN_EPI) { if (wr == 0) PG8_BAR; }
    PG8_BAR;
    if constexpr (Epi::AFTER_DRAIN) { E.fused(acc, cur, wr, wc, fr, fq, lds, wid, lane); S.done(cur); }
#undef PG8_SA
#undef PG8_SB
#undef PG8_STAGE
#undef PG8_LDA
#undef PG8_LDB
#undef PG8_MMA
#undef PG8_WAIT_V
#undef PG8_WAIT_L
#undef PG8_BAR
#undef PG8_SCHED
}
}
constexpr int BATCH = 16, SEQ = 4096, D = 1024, M = BATCH * SEQ;
constexpr int NIN = 5632, FF = 2816, PLE = 256;
constexpr int ATTW = 1536, HGW = 2048, GW = 2048;
constexpr float EPS = 1e-6f;
constexpr float QSCALE = 0.125f * 1.4426950408889634f;
constexpr int NWAVES = 8, NTHR = NWAVES * 64;

constexpr size_t MiB = 1u << 20;
constexpr size_t WS_CTL = 0, CTL_ZERO_BYTES = 1 * MiB;
constexpr size_t WS_WIN = 2 * MiB, WS_WGU = 13 * MiB, WS_WDN = 24 * MiB, WS_WOUT = 30 * MiB, WS_WPG = 32 * MiB, WS_WA = 34 * MiB, WS_WB = 35 * MiB, WS_WPE = 36 * MiB;
constexpr size_t WS_RSTD0 = 37 * MiB;
constexpr size_t WS_LSE = 40 * MiB;
constexpr size_t WS_PB = 48 * MiB;
constexpr size_t WS_XB = 80 * MiB;
constexpr size_t WS_YA = 80 * MiB, WS_YB = 80 * MiB;
constexpr size_t WS_ATT = 208 * MiB;
constexpr size_t WS_HG = 400 * MiB;
constexpr size_t WS_GT = 656 * MiB;
constexpr size_t WS_EST = 912 * MiB;
constexpr size_t WS_DCH = 45 * MiB;
constexpr size_t WS_DSEG = 44 * MiB;
constexpr size_t WS_END = 1024 * MiB;
constexpr int CW_BAR = 4096;
constexpr int CW_SS1 = 65536, CW_SS2 = 2 * 65536, CW_SS3 = 3 * 65536;

constexpr int RING_OFF = 0, RING_BYTES = 131072;
constexpr int LDSCTL_OFF = RING_BYTES, MISC_OFF = LDSCTL_OFF + 320;
constexpr int LDS_BYTES = 163840;

#define GAS __attribute__((address_space(1)))
#define LAS __attribute__((address_space(3)))
#define DI __device__ __forceinline__
typedef unsigned short bf16;
typedef unsigned v4u __attribute__((ext_vector_type(4)));
typedef unsigned v2u __attribute__((ext_vector_type(2)));
typedef float f32x4 __attribute__((ext_vector_type(4)));
typedef GAS unsigned gu32;
#define RLX_AGENT __ATOMIC_RELAXED, __HIP_MEMORY_SCOPE_AGENT
#define LDS_WAIT() asm volatile("s_waitcnt lgkmcnt(0)" ::: "memory")
#define VM_WAIT() asm volatile("s_waitcnt vmcnt(0)" ::: "memory")
DI unsigned f2bf(float f) { unsigned u = __builtin_bit_cast(unsigned, f); return (u + 0x7fffu + ((u >> 16) & 1u)) >> 16; }
DI unsigned pk2(float lo, float hi) { return f2bf(lo) | (f2bf(hi) << 16); }
DI float bflo(unsigned u) { return __builtin_bit_cast(float, u << 16); }
DI float bfhi(unsigned u) { return __builtin_bit_cast(float, u & 0xffff0000u); }
DI float bf2f(bf16 b) { return __builtin_bit_cast(float, (unsigned)b << 16); }
DI float sigmoidf_(float v) { return __builtin_amdgcn_rcpf(1.0f + __expf(-v)); }

#define XB_TMO      128
#define XB_XCNT(j)  (256  + 64 * (j))
#define XB_XSUB(j)  (1280 + 64 * (j))
#define XB_XGEN(j)  (2304 + 64 * (j))
#define XB_TOP      3328
#define XB_TOPGEN   3392
#define XCD_BAR_WORDS 3456
#define XB_SPIN_CAP (1u << 18)

__device__ __forceinline__ unsigned xb_ld(unsigned* p)              { return __hip_atomic_load(p, __ATOMIC_RELAXED, __HIP_MEMORY_SCOPE_AGENT); }
__device__ __forceinline__ unsigned xb_add(unsigned* p, unsigned v) { return __hip_atomic_fetch_add(p, v, __ATOMIC_RELAXED, __HIP_MEMORY_SCOPE_AGENT); }
__device__ __forceinline__ unsigned xb_xcc_id() { return (unsigned)__builtin_amdgcn_s_getreg((3 << 11) | 20) & 0xFu; }
#define XB_SPIN(cond, bar) do { unsigned _sp = 0; while (cond) { __builtin_amdgcn_s_sleep(1); \
    if ((++_sp & 255u) == 0u) { if (xb_ld(&(bar)[XB_TMO])) break; if (_sp > XB_SPIN_CAP) { atomicAdd(&(bar)[XB_TMO], 1u); break; } } } } while (0)

struct XcdBarrier {
    unsigned* bar; unsigned x;
    volatile LAS unsigned* st;
};

__device__ __forceinline__ XcdBarrier xcd_barrier_post(unsigned* bar, volatile LAS unsigned* st) {
    XcdBarrier b; b.bar = bar; b.x = xb_xcc_id(); b.st = st;
    if (threadIdx.x == 0) (void)xb_add(&bar[XB_XCNT(b.x)], 1u);
    return b;
}
__device__ __forceinline__ void xcd_barrier_complete(unsigned* bar, unsigned x, unsigned& nloc, unsigned& nx) {
    const unsigned G = gridDim.x * gridDim.y * gridDim.z;
    unsigned sum, cnt, mine, sp = 0u;
    for (;;) {
        sum = 0u; cnt = 0u; mine = 0u;
#pragma unroll
        for (unsigned j = 0; j < 16; ++j) { const unsigned c = xb_ld(&bar[XB_XCNT(j)]); sum += c; cnt += (c > 0u) ? 1u : 0u; mine = (j == x) ? c : mine; }
        if (sum == G) break;
        __builtin_amdgcn_s_sleep(1);
        if ((++sp & 255u) == 0u) { if (xb_ld(&bar[XB_TMO])) break; if (sp > XB_SPIN_CAP) { atomicAdd(&bar[XB_TMO], 1u); break; } }
    }
    nloc = mine > 0u ? mine : 1u; nx = cnt > 0u ? cnt : 1u;
}

__device__ __forceinline__ void xcd_barrier(const XcdBarrier& b) {
    asm volatile("s_waitcnt vmcnt(0)" ::: "memory");
    __syncthreads();
    if (threadIdx.x == 0) {
        unsigned* bar = b.bar;
        __builtin_amdgcn_s_waitcnt(0);
        unsigned nloc = b.st[0], nx = b.st[1];
        if (nloc == 0u) { xcd_barrier_complete(bar, b.x, nloc, nx); b.st[0] = nloc; b.st[1] = nx; }
        const unsigned old = xb_add(&bar[XB_XSUB(b.x)], 1u);
        const unsigned gen = old / nloc;
        if (old + 1u == (gen + 1u) * nloc) {
            __builtin_amdgcn_fence(__ATOMIC_RELEASE, "agent");
            asm volatile("s_waitcnt vmcnt(0)" ::: "memory");
            const unsigned og = xb_add(&bar[XB_TOP], 1u);
            const unsigned tg = og / nx;
            if (og + 1u == (tg + 1u) * nx) xb_add(&bar[XB_TOPGEN], 1u);
            else XB_SPIN(xb_ld(&bar[XB_TOPGEN]) == tg, bar);
            __builtin_amdgcn_fence(__ATOMIC_ACQUIRE, "agent");
            xb_add(&bar[XB_XGEN(b.x)], 1u);
            asm volatile("s_waitcnt vmcnt(0)" ::: "memory");
        } else {
            XB_SPIN(xb_ld(&bar[XB_XGEN(b.x)]) == gen, bar);
            __builtin_amdgcn_fence(__ATOMIC_ACQUIRE, "agent");
            asm volatile("s_waitcnt vmcnt(0)" ::: "memory");
        }
    }
    __syncthreads();
}

struct EpiArgs {
    const float* rs;
    float* ss;
    const float* xres;
    const bf16* xrb;
    bf16* ob;
    const bf16* gate;
    bf16* att; bf16* hg; bf16* g;
    const float* hg_lb; float* dch;
};
DI void unpack8(const v4u q, float (&f)[8]) { f[0] = bflo(q.x); f[1] = bfhi(q.x); f[2] = bflo(q.y); f[3] = bfhi(q.y); f[4] = bflo(q.z); f[5] = bfhi(q.z); f[6] = bflo(q.w); f[7] = bfhi(q.w); }
DI v4u pack8(const float (&f)[8]) { v4u w; w.x = pg8::cvt_pk_bf16(f[0], f[1]); w.y = pg8::cvt_pk_bf16(f[2], f[3]); w.z = pg8::cvt_pk_bf16(f[4], f[5]); w.w = pg8::cvt_pk_bf16(f[6], f[7]); return w; }

DI void st16_wt(void* p, v4u v) { asm volatile("global_store_dwordx4 %0, %1, off sc1\n\ts_nop 1" :: "v"(p), "v"(v) : "memory"); }
#ifndef WT_STORES
#define WT_STORES 0
#endif
#if WT_STORES == 1
#define ST16(p, v) st16_wt((void*)(p), (v))
#elif WT_STORES == 2
#define ST16(p, v) __builtin_nontemporal_store((v), (v4u*)(p))
#else
#define ST16(p, v) (*(v4u*)(p) = (v))
#endif
template <int N> DI float row_shr(float v) { return __builtin_bit_cast(float, __builtin_amdgcn_update_dpp(0, __builtin_bit_cast(int, v), 0x110 + N, 0xf, 0xf, true)); }
DI float row_last(float v, int lane) { return __builtin_bit_cast(float, __builtin_amdgcn_ds_bpermute((lane | 15) << 2, __builtin_bit_cast(int, v))); }

template <int MODE> struct Epi {
    static constexpr bool PERM = true, AFTER_DRAIN = false;
    static constexpr bool KSPLIT = (MODE == 2);
    EpiArgs a;
    DI void mid(pg8::f32x4 (&acc)[2][2][4][2], const pg8::Unit& u, int wr, int wc, int fr, int fq) const {
        const bf16* gbase = a.gate + (size_t)(u.pm * 256 + wr * 64 + fr) * GW + u.pn * 256 + wc * 32 + 8 * fq;
#pragma unroll
        for (int ai = 0; ai < 2; ++ai)
#pragma unroll
            for (int m = 0; m < 4; ++m)
#pragma unroll
                for (int bj = 0; bj < 2; ++bj) {
                    const bf16* gp = gbase + (size_t)(ai * 128 + m * 16) * GW + bj * 128;
                    float ga[8], gb[8]; unpack8(*(const v4u*)gp, ga); unpack8(*(const v4u*)(gp + 1024), gb);
#pragma unroll
                    for (int i = 0; i < 4; ++i) { acc[ai][bj][m][0][i] *= ga[i] * __builtin_amdgcn_rcpf(fmaxf(gb[i], 1e-30f)); acc[ai][bj][m][1][i] *= ga[4 + i] * __builtin_amdgcn_rcpf(fmaxf(gb[4 + i], 1e-30f)); }
                }
    }
    DI void hgrn_tile(const pg8::f32x4 (&acc)[2][2][4][2], const pg8::Unit& u, int wr, int wc, int fr, int fq) const {
        const int h = u.pn - 6, chb = wc * 32 + 8 * fq, lane = fq * 16 + fr;
        float lbv[8];
        { const f32x4 a0 = *(const f32x4*)(a.hg_lb + h * 128 + chb), a1 = *(const f32x4*)(a.hg_lb + h * 128 + chb + 4), b0 = *(const f32x4*)(a.hg_lb + 512 + h * 128 + chb), b1 = *(const f32x4*)(a.hg_lb + 512 + h * 128 + chb + 4);
#pragma unroll
            for (int i = 0; i < 4; ++i) { lbv[i] = 1.0f / (1.0f + __expf(b0[i] - a0[i])); lbv[4 + i] = 1.0f / (1.0f + __expf(b1[i] - a1[i])); } }
#pragma unroll
        for (int ai = 0; ai < 2; ++ai) {
            const int rowc = u.pm * 256 + ai * 128 + wr * 64;
#pragma unroll
            for (int n = 0; n < 2; ++n) {
                float qt[4][4], kh[4][4], dtot[4];
#pragma unroll
                for (int i = 0; i < 4; ++i) {
                    const float lb = lbv[4 * n + i];
                    float sc[4], kf[4], rt[4];
#pragma unroll
                    for (int m = 0; m < 4; ++m) {
                        const float f = lb + (1.0f - lb) * sigmoidf_(acc[ai][1][m][n][i]);
                        kf[m] = 1.0f - f;
                        float s = __logf(f);
                        s += row_shr<1>(s); s += row_shr<2>(s); s += row_shr<4>(s); s += row_shr<8>(s);
                        sc[m] = s; rt[m] = row_last(s, lane);
                    }
                    const float tot = (rt[0] + rt[1]) + (rt[2] + rt[3]);
                    float off = 0.f;
#pragma unroll
                    for (int m = 0; m < 4; ++m) { const float b = sc[m] + off; off += rt[m];
                        qt[m][i] = acc[ai][0][m][n][i] * __expf(fminf(b - tot, 80.0f));
                        kh[m][i] = kf[m] * __expf(tot - b); }
                    dtot[i] = __expf(tot);
                }
#pragma unroll
                for (int m = 0; m < 4; ++m) { const int row = rowc + m * 16 + fr; bf16* dst = a.hg + ((size_t)((row >> 12) * 4 + h) * SEQ + (row & (SEQ - 1))) * 128 + chb + 4 * n;
                    v2u wq, wk; wq.x = pg8::cvt_pk_bf16(qt[m][0], qt[m][1]); wq.y = pg8::cvt_pk_bf16(qt[m][2], qt[m][3]); wk.x = pg8::cvt_pk_bf16(kh[m][0], kh[m][1]); wk.y = pg8::cvt_pk_bf16(kh[m][2], kh[m][3]);
                    *(v2u*)dst = wq; *(v2u*)(dst + (size_t)M * 512) = wk; }
                if (fr == 0) { float* dp = a.dch + ((size_t)(rowc >> 6) * 4 + h) * 128 + chb + 4 * n;
                    *(f32x4*)dp = (f32x4){dtot[0], dtot[1], dtot[2], dtot[3]}; }
            }
        }
    }
    DI void operator()(const pg8::f32x4 (&acc)[2][2][4][2], const pg8::Unit& u, int wr, int wc, int fr, int fq) const {
        const int row0 = u.pm * 256 + wr * 64 + fr;
        const int colt = u.pn * 256 + wc * 32 + 8 * fq;
        int kind = 0;
        if (MODE == 1) kind = (u.pn < 2) ? 0 : (u.pn < 6) ? 1 : (u.pn < 10) ? 5 : (u.pn < 12) ? 2 : (u.pn < 14) ? 3 : 4;
        if constexpr (MODE == 1) { if (kind == 5) { hgrn_tile(acc, u, wr, wc, fr, fq); return; } }
#pragma unroll
        for (int ai = 0; ai < 2; ++ai)
#pragma unroll
            for (int m = 0; m < 4; ++m) {
                const int row = row0 + ai * 128 + m * 16;
                if constexpr (MODE == 1) {
#pragma unroll
                    for (int bj = 0; bj < 2; ++bj) {
                        const int col = colt + bj * 128;
                        float v[8];
#pragma unroll
                        for (int i = 0; i < 4; ++i) { v[i] = acc[ai][bj][m][0][i]; v[4 + i] = acc[ai][bj][m][1][i]; }
                        bf16* dst;
                        const int bb = row >> 12, tt_ = row & (SEQ - 1);
                        if (kind <= 1) {
                            if (kind == 0) {
#pragma unroll
                                for (int i = 0; i < 8; ++i) v[i] *= QSCALE;
                            }
                            const int which = col >> 9, cw = col & 511;
                            dst = a.att + (size_t)which * ((size_t)M * 512) + ((size_t)(bb * 8 + (cw >> 6)) * SEQ + tt_) * 64 + (cw & 63);
                        } else if (kind == 2 || kind == 3) {
                            if (kind == 3) {
#pragma unroll
                                for (int i = 0; i < 8; ++i) v[i] = v[i] * sigmoidf_(v[i]);
                            }
                            const int cw = (col - 2560) & 511;
                            dst = a.hg + (size_t)kind * ((size_t)M * 512) + ((size_t)(bb * 4 + (cw >> 7)) * SEQ + tt_) * 128 + (cw & 127);
                        } else {
#pragma unroll
                            for (int i = 0; i < 8; ++i) v[i] = sigmoidf_(v[i]);
                            dst = a.g + (size_t)row * GW + (col - 3584);
                        }
                        ST16(dst, pack8(v));
                    }
                } else if constexpr (MODE == 2) {
#pragma unroll
                    for (int bj = 0; bj < 2; ++bj) {
                        const int col = colt + bj * 128;
                        float gb[8], v[8];
                        unpack8(*(const v4u*)(a.gate + (size_t)row * GW + 1024 + col), gb);
#pragma unroll
                        for (int i = 0; i < 4; ++i) { v[i] = fmaxf(gb[i], 1e-30f) * acc[ai][bj][m][0][i]; v[4 + i] = fmaxf(gb[4 + i], 1e-30f) * acc[ai][bj][m][1][i]; }
                        *(v4u*)(a.ob + (size_t)row * D + col) = pack8(v);
                    }
                } else if constexpr (MODE == 4 || MODE == 6 || MODE == 8) {
                    float r = 0.f;
                    if constexpr (MODE == 8) r = __builtin_amdgcn_rsqf(a.rs[row] * (1.0f / D) + EPS);
                    float s = 0.f;
#pragma unroll
                    for (int bj = 0; bj < 2; ++bj) {
                        const int col = colt + bj * 128;
                        const size_t off = (size_t)row * D + col;
                        float xr[8];
                        if constexpr (MODE == 4) { const f32x4 x0 = *(const f32x4*)(a.xres + off), x1 = *(const f32x4*)(a.xres + off + 4);
#pragma unroll
                            for (int i = 0; i < 4; ++i) { xr[i] = x0[i]; xr[4 + i] = x1[i]; } }
                        else unpack8(*(const v4u*)(a.xrb + off), xr);
                        float v[8];
#pragma unroll
                        for (int i = 0; i < 4; ++i) { v[i] = acc[ai][bj][m][0][i]; v[4 + i] = acc[ai][bj][m][1][i]; }
                        if constexpr (MODE == 8) {
                            float e[8]; unpack8(*(const v4u*)(a.gate + off), e);
#pragma unroll
                            for (int i = 0; i < 8; ++i) v[i] = e[i] * sigmoidf_(v[i] * r);
                        }
#pragma unroll
                        for (int i = 0; i < 8; ++i) { v[i] += xr[i]; s += v[i] * v[i]; }
                        *(v4u*)(a.ob + off) = pack8(v);
                    }
                    s += __shfl_xor(s, 16); s += __shfl_xor(s, 32);
                    if (fq == 0) atomicAdd(a.ss + row, s);
                } else if constexpr (MODE == 5) {
                    const float r = __builtin_amdgcn_rsqf(a.rs[row] * (1.0f / D) + EPS);
                    const int hcol = u.pn * 128 + wc * 32 + 8 * fq;
                    float v[8];
#pragma unroll
                    for (int i = 0; i < 4; ++i) {
                        const float g0 = acc[ai][0][m][0][i] * r, u0 = acc[ai][1][m][0][i] * r, g1 = acc[ai][0][m][1][i] * r, u1 = acc[ai][1][m][1][i] * r;
                        v[i] = g0 * sigmoidf_(g0) * u0; v[4 + i] = g1 * sigmoidf_(g1) * u1;
                    }
                    ST16(a.ob + (size_t)row * FF + hcol, pack8(v));
                } else {
#pragma unroll
                    for (int bj = 0; bj < 2; ++bj) {
                        const int col = colt + bj * 128;
                        float v[8];
#pragma unroll
                        for (int i = 0; i < 4; ++i) { v[i] = acc[ai][bj][m][0][i]; v[4 + i] = acc[ai][bj][m][1][i]; }
                        *(v4u*)(a.ob + (size_t)row * D + col) = pack8(v);
                    }
                }
            }
    }
};

DI float wave_sum(float v) {
#pragma unroll
    for (int o = 1; o < 64; o <<= 1) v += __shfl_xor(v, o);
    return v;
}
DI void p0_transpose_item(const float* W, int K, int N, const float* gain, bf16* WT, int GU, LAS float* scr, int item, int lane, int pitch = 0, int coff = 0) {
    if (pitch == 0) pitch = K;
    const int nblk = N / 32, kb = item / nblk, nb = item % nblk, k0 = 64 * kb, n0 = 32 * nb;
    int s0 = n0;
    if (GU == 1) { const int tile = n0 >> 8, j = n0 & 255; s0 = (j < 128) ? tile * 128 + j : FF + tile * 128 + (j - 128); }
    if (GU == 2) { const int tile = n0 >> 8, j = n0 & 255; if (tile >= 6 && tile < 10) s0 = (j < 128) ? 1536 + (tile - 6) * 128 + j : 2048 + (tile - 6) * 128 + (j - 128); }
    float wv[32];
#pragma unroll
    for (int i = 0; i < 32; ++i) wv[i] = W[(size_t)(k0 + 2 * i + (lane >> 5)) * N + s0 + (lane & 31)];
    if (gain) {
#pragma unroll
        for (int i = 0; i < 32; ++i) wv[i] *= gain[k0 + 2 * i + (lane >> 5)];
    }
#pragma unroll
    for (int i = 0; i < 32; ++i) scr[(2 * i + (lane >> 5)) * 33 + (lane & 31)] = wv[i];
    LDS_WAIT(); asm volatile("" ::: "memory");
    const int c = lane & 7;
#pragma unroll
    for (int j = 0; j < 4; ++j) { const int n = (lane >> 3) + 8 * j; const LAS float* s = scr + (8 * c) * 33 + n;
        v4u o; o.x = pg8::cvt_pk_bf16(s[0 * 33], s[1 * 33]); o.y = pg8::cvt_pk_bf16(s[2 * 33], s[3 * 33]); o.z = pg8::cvt_pk_bf16(s[4 * 33], s[5 * 33]); o.w = pg8::cvt_pk_bf16(s[6 * 33], s[7 * 33]);
        *(GAS v4u*)(WT + (size_t)(n0 + n) * pitch + coff + k0 + 8 * c) = o; }
    LDS_WAIT(); asm volatile("" ::: "memory");
}

struct Args { const float* in[16]; float* out; unsigned char* ws; };

typedef short s16x4 __attribute__((ext_vector_type(4)));
typedef float f32x16 __attribute__((ext_vector_type(16)));
typedef float f32x2_t __attribute__((ext_vector_type(2))); typedef __bf16 bf16x2_t __attribute__((ext_vector_type(2)));
typedef short v4i16_t __attribute__((ext_vector_type(4)));
DI unsigned cvtpk_s(float lo, float hi) { f32x2_t v = {lo, hi}; bf16x2_t b = __builtin_convertvector(v, bf16x2_t); return __builtin_bit_cast(unsigned, b); }
DI s16x4 vtr(const LAS unsigned char* p) { return __builtin_bit_cast(s16x4, __builtin_amdgcn_ds_read_tr16_b64_v4i16((LAS v4i16_t*)p)); }
DI int crow(int i, int hh) { return (i & 3) + 8 * (i >> 2) + 4 * hh; }
DI s16x4 vtr_asm(unsigned addr) { s16x4 r; asm volatile("ds_read_b64_tr_b16 %0, %1" : "=v"(r) : "v"(addr) : "memory"); return r; }
#define TR_WAIT4(a, b, c, d) do { asm volatile("s_waitcnt lgkmcnt(0)" : "+v"(a), "+v"(b), "+v"(c), "+v"(d) :: "memory"); __builtin_amdgcn_sched_barrier(0); } while (0)
DI pg8::bf16x8 pack_step(const f32x16& x, int s) {
    v4u p; p.x = cvtpk_s(x[8 * s], x[8 * s + 1]); p.y = cvtpk_s(x[8 * s + 2], x[8 * s + 3]); p.z = cvtpk_s(x[8 * s + 4], x[8 * s + 5]); p.w = cvtpk_s(x[8 * s + 6], x[8 * s + 7]);
    return __builtin_bit_cast(pg8::bf16x8, p);
}
#define MFMA32(a, b, c) __builtin_amdgcn_mfma_f32_32x32x16_bf16((a), (b), (c), 0, 0, 0)
#define HBAR() do { asm volatile("s_waitcnt lgkmcnt(0)" ::: "memory"); __builtin_amdgcn_s_barrier(); asm volatile("" ::: "memory"); } while (0)

#define MFMA16(a, b, c) __builtin_amdgcn_mfma_f32_16x16x32_bf16((a), (b), (c), 0, 0, 0)
struct A16Blk { int d, blk_start, res; };
DI A16Blk a16_blk(int s, int sp) {
    const int pass = s >> 4, bi = s & 15, d = (pass == 0) ? 16 : (pass == 1) ? 4 : 1, bpr = 16 / d;
    A16Blk B; B.d = d; B.res = bi / bpr; B.blk_start = sp * (2048 / d) + (bi % bpr) * 128; return B;
}
DI void a16_dma(LAS unsigned char* kbuf, LAS unsigned char* vbuf, LAS unsigned char* qbuf, const bf16* Qh, const bf16* Kh, const bf16* Vh, const A16Blk& B, int wave, int lane) {
#pragma unroll
    for (int i = 0; i < 4; ++i) {
        const int pc = wave * 4 + i, kk = pc * 8 + (lane >> 3);
        int l = B.blk_start - 128 + kk; if (l < 0) l = 0;
        const size_t rowi = (size_t)(l * B.d + B.res) * 64;
        const int ck = (lane & 7) ^ ((kk >> 1) & 7);
        const int cv = ((((lane & 7) >> 1) ^ ((kk >> 1) & 3)) << 1) + (lane & 1);
        __builtin_amdgcn_global_load_lds((const unsigned*)(Kh + rowi + ck * 8), (LAS unsigned*)(kbuf + pc * 1024), 16, 0, 0);
        __builtin_amdgcn_global_load_lds((const unsigned*)(Vh + rowi + cv * 8), (LAS unsigned*)(vbuf + pc * 1024), 16, 0, 0);
    }
#pragma unroll
    for (int i = 0; i < 2; ++i) {
        const int qr = i * 8 + (lane >> 3);
        const size_t rowq = (size_t)((B.blk_start + 16 * wave + qr) * B.d + B.res) * 64;
        __builtin_amdgcn_global_load_lds((const unsigned*)(Qh + rowq + (((lane & 7) ^ ((qr >> 1) & 7)) << 3)), (LAS unsigned*)(qbuf + i * 1024), 16, 0, 0);
    }
}
DI void attn16_unit(LAS unsigned char* lds, const bf16* ATT, bf16* Y, float* LSE, int b, int h, int sp, int tid) {
    const int lane = tid & 63, wave = __builtin_amdgcn_readfirstlane(tid >> 6);
    const int c = lane & 15, g = lane >> 4, tq4 = c >> 2, tp = c & 3;
    const bf16* Qh = ATT + (size_t)(b * 8 + h) * SEQ * 64; const bf16* Kh = Qh + (size_t)M * 512; const bf16* Vh = Kh + (size_t)M * 512;
    constexpr int NS = 48;
    { const A16Blk B0 = a16_blk(0, sp); a16_dma(lds, lds + 32768, lds + RING_BYTES + wave * 2048, Qh, Kh, Vh, B0, wave, lane); }
    VM_WAIT();
#pragma unroll 2
    for (int s = 0; s < NS; ++s) {
        const A16Blk B = a16_blk(s, sp);
        const int bs = s & 1, pass = s >> 4;
        LAS unsigned char* kb = lds + bs * 65536; LAS unsigned char* vb = kb + 32768;
        LAS unsigned char* qs = lds + RING_BYTES + bs * 16384 + wave * 2048;
        if (s == 16 || s == 32) {
            VM_WAIT(); HBAR();
            __builtin_amdgcn_fence(__ATOMIC_ACQUIRE, "agent");
            VM_WAIT();
        }
        asm volatile("s_waitcnt vmcnt(3)" ::: "memory"); HBAR();
        const size_t rowb = (size_t)b * SEQ + B.res;
        const int q0 = B.blk_start + 16 * wave;
        bf16* ybase = Y + rowb * 1024 + h * 64 + (lane & 7) * 8;
        const size_t tokc = rowb + (size_t)((q0 + c) * B.d);
        v4u prw0, prw1; float lp;
        if (pass > 0) {
            asm volatile("global_load_dwordx4 %0, %1, off" : "=v"(prw0) : "v"(ybase + (size_t)((q0 + (lane >> 3)) * B.d) * 1024) : "memory");
            asm volatile("global_load_dwordx4 %0, %1, off" : "=v"(prw1) : "v"(ybase + (size_t)((q0 + (lane >> 3) + 8) * B.d) * 1024) : "memory");
            asm volatile("global_load_dword %0, %1, off" : "=v"(lp) : "v"(LSE + tokc * 8 + h) : "memory");
        } else asm volatile("" : "=v"(prw0), "=v"(prw1), "=v"(lp));
        { const A16Blk Bn = a16_blk(s + 1 < NS ? s + 1 : s, sp);
            a16_dma(lds + (bs ^ 1) * 65536, lds + (bs ^ 1) * 65536 + 32768, lds + RING_BYTES + (bs ^ 1) * 16384 + wave * 2048, Qh, Kh, Vh, Bn, wave, lane); }
        pg8::bf16x8 qf[2];
#pragma unroll
        for (int sx = 0; sx < 2; ++sx) qf[sx] = *(const LAS pg8::bf16x8*)(qs + c * 128 + (((4 * sx + g) ^ ((c >> 1) & 7)) << 4));
        f32x4 S[10];
#pragma unroll
        for (int kt = 0; kt < 9; ++kt) {
            S[kt] = (f32x4){0.f, 0.f, 0.f, 0.f};
            const int key = 16 * wave + 16 * kt + c;
#pragma unroll
            for (int sx = 0; sx < 2; ++sx) {
                const pg8::bf16x8 kf = *(const LAS pg8::bf16x8*)(kb + key * 128 + (((4 * sx + g) ^ ((key >> 1) & 7)) << 4));
                S[kt] = MFMA16(kf, qf[sx], S[kt]);
            }
        }
        S[9] = (f32x4){0.f, 0.f, 0.f, 0.f};
        const float NEG = -1e30f;
#pragma unroll
        for (int i = 0; i < 4; ++i) { const int kr = 4 * g + i; S[0][i] = (kr >= c) ? S[0][i] : NEG; S[8][i] = (kr <= c) ? S[8][i] : NEG; }
        if (B.blk_start == 0) {
#pragma unroll
            for (int kt = 0; kt < 8; ++kt) if (wave + kt < 8) S[kt] = (f32x4){NEG, NEG, NEG, NEG};
        }
        float mx = NEG;
#pragma unroll
        for (int kt = 0; kt < 9; ++kt)
#pragma unroll
            for (int i = 0; i < 4; ++i) mx = fmaxf(mx, S[kt][i]);
        mx = fmaxf(mx, __shfl_xor(mx, 16)); mx = fmaxf(mx, __shfl_xor(mx, 32));
        float l = 0.f;
#pragma unroll
        for (int kt = 0; kt < 9; ++kt)
#pragma unroll
            for (int i = 0; i < 4; ++i) { const float pv = __builtin_amdgcn_exp2f(S[kt][i] - mx); S[kt][i] = pv; l += pv; }
        l += __shfl_xor(l, 16); l += __shfl_xor(l, 32);
        f32x4 O[4];
#pragma unroll
        for (int t = 0; t < 4; ++t) O[t] = (f32x4){0.f, 0.f, 0.f, 0.f};
#pragma unroll
        for (int j = 0; j < 5; ++j) {
            v4u pw; pw.x = cvtpk_s(S[2 * j][0], S[2 * j][1]); pw.y = cvtpk_s(S[2 * j][2], S[2 * j][3]); pw.z = cvtpk_s(S[2 * j + 1][0], S[2 * j + 1][1]); pw.w = cvtpk_s(S[2 * j + 1][2], S[2 * j + 1][3]);
            const pg8::bf16x8 pb = __builtin_bit_cast(pg8::bf16x8, pw);
            const int klo = 16 * wave + 32 * j + 4 * g + tq4, khi = (j < 4) ? klo + 16 : klo;
            const unsigned vb32 = (unsigned)(size_t)vb;
#define V16A(k_, t_) (vb32 + (k_) * 128 + (((t_) ^ (((k_) >> 1) & 3)) << 5) + 8 * tp)
            s16x4 l0 = vtr_asm(V16A(klo, 0)), h0 = vtr_asm(V16A(khi, 0)), l1 = vtr_asm(V16A(klo, 1)), h1 = vtr_asm(V16A(khi, 1));
            s16x4 l2 = vtr_asm(V16A(klo, 2)), h2 = vtr_asm(V16A(khi, 2)), l3 = vtr_asm(V16A(klo, 3)), h3 = vtr_asm(V16A(khi, 3));
#undef V16A
            asm volatile("s_waitcnt lgkmcnt(0)" : "+v"(l0), "+v"(h0), "+v"(l1), "+v"(h1), "+v"(l2), "+v"(h2), "+v"(l3), "+v"(h3) :: "memory"); __builtin_amdgcn_sched_barrier(0);
            O[0] = MFMA16(__builtin_shufflevector(l0, h0, 0, 1, 2, 3, 4, 5, 6, 7), pb, O[0]);
            O[1] = MFMA16(__builtin_shufflevector(l1, h1, 0, 1, 2, 3, 4, 5, 6, 7), pb, O[1]);
            O[2] = MFMA16(__builtin_shufflevector(l2, h2, 0, 1, 2, 3, 4, 5, 6, 7), pb, O[2]);
            O[3] = MFMA16(__builtin_shufflevector(l3, h3, 0, 1, 2, 3, 4, 5, 6, 7), pb, O[3]);
        }
        asm volatile("s_waitcnt vmcnt(10)" : "+v"(prw0), "+v"(prw1), "+v"(lp) :: "memory");
        float lse = mx + __builtin_amdgcn_logf(l);
        const float invl = 1.0f / l;
        const bool mrg = pass > 0;
        const float lpp = mrg ? lp : lse;
        const float mm = fmaxf(lpp, lse), ep = __builtin_amdgcn_exp2f(lpp - mm), en = __builtin_amdgcn_exp2f(lse - mm), inv = 1.0f / (ep + en);
        const float wp = ep * inv, wn = mrg ? en * inv * invl : invl;
        lse = mrg ? mm + __builtin_amdgcn_logf(ep + en) : lse;
        LDS_WAIT();
        { const int qr = (lane >> 3); *(LAS v4u*)(qs + qr * 128 + (((lane & 7) ^ (qr & 7)) << 4)) = prw0; *(LAS v4u*)(qs + (qr + 8) * 128 + (((lane & 7) ^ (qr & 7)) << 4)) = prw1; }
        LDS_WAIT();
#pragma unroll
        for (int t = 0; t < 4; ++t) {
            LAS unsigned char* ap = qs + c * 128 + (((2 * t + (g >> 1)) ^ (c & 7)) << 4) + 8 * (g & 1);
            const v2u pq = *(const LAS v2u*)ap;
            float o0 = O[t][0] * wn, o1 = O[t][1] * wn, o2 = O[t][2] * wn, o3 = O[t][3] * wn;
            const float m0 = o0 + wp * bflo(pq.x), m1 = o1 + wp * bfhi(pq.x), m2 = o2 + wp * bflo(pq.y), m3 = o3 + wp * bfhi(pq.y);
            o0 = mrg ? m0 : o0; o1 = mrg ? m1 : o1; o2 = mrg ? m2 : o2; o3 = mrg ? m3 : o3;
            v2u w; w.x = cvtpk_s(o0, o1); w.y = cvtpk_s(o2, o3);
            *(LAS v2u*)ap = w;
        }
        LDS_WAIT();
        v4u ow[2];
#pragma unroll
        for (int j = 0; j < 2; ++j) { const int qr = (lane >> 3) + 8 * j; ow[j] = *(const LAS v4u*)(qs + qr * 128 + (((lane & 7) ^ (qr & 7)) << 4)); }
#pragma unroll
        for (int j = 0; j < 2; ++j) *(v4u*)(ybase + (size_t)((q0 + (lane >> 3) + 8 * j) * B.d) * 1024) = ow[j];
        if (g == 0) LSE[tokc * 8 + h] = lse;
    }
    VM_WAIT(); HBAR();
}

constexpr int H_STAGE = 49152, H_QT = 0, H_KH = 16384, H_VV = 32768, H_ST = 98304, H_PSS = RING_BYTES + 1024;
DI int fsw(int s) { return ((s & 3) << 2) | ((s >> 2) & 3); }
DI pg8::bf16x8 rowfrag(const LAS unsigned char* base, int row, int ks, int hh) { return *(const LAS pg8::bf16x8*)(base + row * 256 + (((2 * ks + hh) ^ fsw(row)) << 4)); }

template <int NIMG> DI void hgrn_dma(LAS unsigned char* stg, const bf16* HG, size_t row0, int h, int wave, int lane) {
    const int t4 = lane >> 4, pc = lane & 15;
#pragma unroll
    for (int i = 0; i < 2 * NIMG; ++i) {
        const int p = wave * 2 * NIMG + i;
        const int img = p >> 4, pp = p & 15, t = pp * 4 + t4;
        const int im = (NIMG == 3) ? img : img + 1;
        int c;
        if (im < 2) c = pc ^ fsw(t); else c = (((pc >> 2) ^ (t & 3)) << 2) + (pc & 3);
        const bf16* src = HG + (size_t)im * ((size_t)M * 512) + ((size_t)((row0 >> 12) * 4 + h) * SEQ + (row0 & (SEQ - 1)) + t) * 128 + c * 8;
        __builtin_amdgcn_global_load_lds((const unsigned*)src, (LAS unsigned*)(stg + im * 16384 + pp * 1024), 16, 0, 0);
    }
}

DI void hgrn_vfrags(const LAS unsigned char* stg, pg8::bf16x8 (&vf)[2][2], int vt, int hh, int tq, int tp, int tblk) {
    const unsigned vb32 = (unsigned)(size_t)stg + H_VV;
    const int k0 = 4 * hh + tq;
#define HVA(k_) (vb32 + (k_) * 256 + ((vt ^ ((k_) & 3)) << 6) + 32 * tblk + 8 * tp)
    s16x4 a0 = vtr_asm(HVA(k0)), a1 = vtr_asm(HVA(k0 + 8)), a2 = vtr_asm(HVA(k0 + 16)), a3 = vtr_asm(HVA(k0 + 24));
    s16x4 a4 = vtr_asm(HVA(k0 + 32)), a5 = vtr_asm(HVA(k0 + 40)), a6 = vtr_asm(HVA(k0 + 48)), a7 = vtr_asm(HVA(k0 + 56));
#undef HVA
    asm volatile("s_waitcnt lgkmcnt(0)" : "+v"(a0), "+v"(a1), "+v"(a2), "+v"(a3), "+v"(a4), "+v"(a5), "+v"(a6), "+v"(a7) :: "memory"); __builtin_amdgcn_sched_barrier(0);
    vf[0][0] = __builtin_shufflevector(a0, a1, 0, 1, 2, 3, 4, 5, 6, 7); vf[0][1] = __builtin_shufflevector(a2, a3, 0, 1, 2, 3, 4, 5, 6, 7);
    vf[1][0] = __builtin_shufflevector(a4, a5, 0, 1, 2, 3, 4, 5, 6, 7); vf[1][1] = __builtin_shufflevector(a6, a7, 0, 1, 2, 3, 4, 5, 6, 7);
}
DI void hgrn_update(const LAS unsigned char* stg, f32x16 (&Sacc)[2], const pg8::bf16x8 (&vf)[2][2], int tt, int hh, int tq, int tp, int tblk) {
    const unsigned kb32 = (unsigned)(size_t)stg + H_KH;
    const int k0 = 4 * hh + tq;
#pragma unroll
    for (int j = 0; j < 2; ++j) {
        const int kt = 2 * tt + j, cch = 4 * kt + 2 * tblk + (tp >> 1);
#define HKA(k_) (kb32 + (k_) * 256 + ((cch ^ fsw(k_)) << 4) + 8 * (tp & 1))
#pragma unroll
        for (int st = 0; st < 2; ++st) {
            s16x4 a0 = vtr_asm(HKA(k0 + 32 * st)), a1 = vtr_asm(HKA(k0 + 32 * st + 8)), a2 = vtr_asm(HKA(k0 + 32 * st + 16)), a3 = vtr_asm(HKA(k0 + 32 * st + 24));
            TR_WAIT4(a0, a1, a2, a3);
            Sacc[j] = MFMA32(vf[st][0], __builtin_shufflevector(a0, a1, 0, 1, 2, 3, 4, 5, 6, 7), Sacc[j]);
            Sacc[j] = MFMA32(vf[st][1], __builtin_shufflevector(a2, a3, 0, 1, 2, 3, 4, 5, 6, 7), Sacc[j]);
        }
#undef HKA
    }
}

DI void hgrn_dmaA(LAS unsigned char* lds, int st, const bf16* HG, const float* DCH, size_t row0, int h, int wave, int lane) {
    hgrn_dma<2>(lds + st * 32768, HG, row0, h, wave, lane);
    if (wave < 2) __builtin_amdgcn_global_load_lds((const unsigned*)(DCH + ((row0 >> 6) * 4 + h) * 128 + wave * 64 + lane), (LAS unsigned*)(lds + 114688 + st * 512 + wave * 256), 4, 0, 0);
}
DI void hgrn_passA(LAS unsigned char* lds, const bf16* HG, const float* DCH, float* EST, float* DSEG, int bx, int G, int tid) {
    const int lane = tid & 63, wave = __builtin_amdgcn_readfirstlane(tid >> 6), vt = wave >> 1, tt = wave & 1;
    const int r = lane & 31, hh = lane >> 5, i16 = lane & 15, tq = i16 >> 2, tp = i16 & 3, tblk = (lane >> 4) & 1;
    const int nu = (bx < 1024) ? (1024 - bx + G - 1) / G : 0, nci = nu * 4;
    if (nci == 0) return;
    f32x16 Sacc[2]; float dprod[2] = {1.f, 1.f};
#define PA_ROW(ci_) ((size_t)(((bx + ((ci_) >> 2) * G) & 63) >> 2) * SEQ + ((bx + ((ci_) >> 2) * G) >> 6) * 256 + ((ci_) & 3) * 64)
#define PA_H(ci_) (((bx + ((ci_) >> 2) * G) & 63) & 3)
    hgrn_dmaA(lds, 0, HG, DCH, PA_ROW(0), PA_H(0), wave, lane);
    if (nci > 1) hgrn_dmaA(lds, 1, HG, DCH, PA_ROW(1), PA_H(1), wave, lane);
    if (nci > 1) { if (wave < 2) asm volatile("s_waitcnt vmcnt(5)" ::: "memory"); else asm volatile("s_waitcnt vmcnt(4)" ::: "memory"); } else VM_WAIT();
    HBAR();
    int st = 0;
    for (int ci = 0; ci < nci; ++ci) {
        const int u = bx + (ci >> 2) * G, c = ci & 3, bh = u & 63, seg = u >> 6, sid = bh * 16 + seg;
        LAS unsigned char* stg = lds + st * 32768;
        const LAS float* DV = (const LAS float*)(lds + 114688 + st * 512);
        const int st2 = (st == 0) ? 2 : st - 1;
        if (ci + 2 < nci) hgrn_dmaA(lds, st2, HG, DCH, PA_ROW(ci + 2), PA_H(ci + 2), wave, lane);
        if (c == 0) {
#pragma unroll
            for (int j = 0; j < 2; ++j) { dprod[j] = 1.f;
#pragma unroll
                for (int i = 0; i < 16; ++i) Sacc[j][i] = 0.f; }
        }
#pragma unroll
        for (int j = 0; j < 2; ++j) { const float dk = DV[32 * (2 * tt + j) + r]; dprod[j] *= dk;
#pragma unroll
            for (int i = 0; i < 16; ++i) Sacc[j][i] *= dk; }
        pg8::bf16x8 vf[2][2];
        hgrn_vfrags(stg, vf, vt, hh, tq, tp, tblk);
        hgrn_update(stg, Sacc, vf, tt, hh, tq, tp, tblk);
        if (c == 3) {
#pragma unroll
            for (int j = 0; j < 2; ++j)
#pragma unroll
                for (int i = 0; i < 16; ++i) EST[(size_t)sid * 16384 + (32 * vt + crow(i, hh)) * 128 + 32 * (2 * tt + j) + r] = Sacc[j][i];
            if (vt == 0 && hh == 0) { DSEG[sid * 128 + 64 * tt + r] = dprod[0]; DSEG[sid * 128 + 64 * tt + 32 + r] = dprod[1]; }
        }
        if (ci + 2 < nci) { if (wave < 2) asm volatile("s_waitcnt vmcnt(5)" ::: "memory"); else asm volatile("s_waitcnt vmcnt(4)" ::: "memory"); } else VM_WAIT();
        HBAR();
        st = (st == 2) ? 0 : st + 1;
    }
#undef PA_ROW
#undef PA_H
}
DI void hgrn_passB(float* EST, const float* DSEG, int bx, int G, int tid) {
    for (int w = bx; w < 256; w += G) {
        const int bh = w >> 2, e0 = (w & 3) * 4096 + tid * 8, k0 = e0 & 127;
        f32x4 s0 = {0.f, 0.f, 0.f, 0.f}, s1 = {0.f, 0.f, 0.f, 0.f};
#pragma unroll 5
        for (int seg = 1; seg < 16; ++seg) {
            const int sp = bh * 16 + seg - 1;
            const f32x4 d0 = *(const f32x4*)(DSEG + sp * 128 + k0), d1 = *(const f32x4*)(DSEG + sp * 128 + k0 + 4);
            const f32x4 x0 = *(const f32x4*)(EST + (size_t)sp * 16384 + e0), x1 = *(const f32x4*)(EST + (size_t)sp * 16384 + e0 + 4);
            s0 = d0 * s0 + x0; s1 = d1 * s1 + x1;
            *(f32x4*)(EST + (size_t)sp * 16384 + e0) = s0; *(f32x4*)(EST + (size_t)sp * 16384 + e0 + 4) = s1;
        }
    }
}
DI void hgrn_passC(LAS unsigned char* lds, const bf16* HG, const float* DCH, const float* hg_norm, const float* SST, bf16* YB, int bx, int G, int tid) {
    const int lane = tid & 63, wave = __builtin_amdgcn_readfirstlane(tid >> 6), vt = wave >> 1, tt = wave & 1;
    const int r = lane & 31, hh = lane >> 5, i16 = lane & 15, tq = i16 >> 2, tp = i16 & 3, tblk = (lane >> 4) & 1;
    const int nu = (bx < 1024) ? (1024 - bx + G - 1) / G : 0, nci = nu * 4;
    if (nci == 0) return;
    f32x16 Sacc[2]; float dnext[2];
    if (tid < 128) ((LAS float*)(lds + H_PSS + 1024))[tid] = hg_norm[tid];
    { const int u = bx, bh = u & 63, seg = u >> 6; const size_t row0 = (size_t)(bh >> 2) * SEQ + seg * 256;
        hgrn_dma<3>(lds, HG, row0, bh & 3, wave, lane);
        const float* dp = DCH + ((row0 >> 6) * 4 + (bh & 3)) * 128;
        dnext[0] = dp[64 * tt + r]; dnext[1] = dp[64 * tt + 32 + r]; }
    VM_WAIT(); HBAR();
    for (int ci = 0; ci < nci; ++ci) {
        const int u = bx + (ci >> 2) * G, c = ci & 3, bh = u & 63, seg = u >> 6, h = bh & 3, sid = bh * 16 + seg;
        const size_t row0 = (size_t)(bh >> 2) * SEQ + seg * 256 + c * 64;
        LAS unsigned char* stg = lds + (ci & 1) * H_STAGE;
        const float dcur[2] = {dnext[0], dnext[1]};
        if (c == 0) {
#pragma unroll
            for (int j = 0; j < 2; ++j)
#pragma unroll
                for (int i = 0; i < 16; ++i) Sacc[j][i] = (seg > 0) ? SST[(size_t)(sid - 1) * 16384 + (32 * vt + crow(i, hh)) * 128 + 32 * (2 * tt + j) + r] : 0.f;
        }
        if (ci + 1 < nci) {
            const int u2 = bx + ((ci + 1) >> 2) * G, bh2 = u2 & 63; const size_t row2 = (size_t)(bh2 >> 2) * SEQ + (u2 >> 6) * 256 + ((ci + 1) & 3) * 64;
            const float* dp = DCH + ((row2 >> 6) * 4 + (bh2 & 3)) * 128;
            dnext[0] = dp[64 * tt + r]; dnext[1] = dp[64 * tt + 32 + r];
            hgrn_dma<3>(lds + ((ci + 1) & 1) * H_STAGE, HG, row2, bh2 & 3, wave, lane);
        }
        const int nt_ = tid >> 3, nv0 = (tid & 7) * 16;
        const size_t nrow = row0 + nt_;
        const bf16* gp = HG + (size_t)3 * ((size_t)M * 512) + ((size_t)((nrow >> 12) * 4 + h) * SEQ + (nrow & (SEQ - 1))) * 128 + nv0;
        const v4u gq0 = *(const v4u*)gp, gq1 = *(const v4u*)(gp + 8);
#pragma unroll
        for (int j = 0; j < 2; ++j) { const int kk = 32 * (2 * tt + j) + r;
#pragma unroll
            for (int i = 0; i < 16; ++i) { Sacc[j][i] *= dcur[j]; const int v = 32 * vt + crow(i, hh);
                *(LAS bf16*)(lds + H_ST + v * 256 + (((kk >> 3) ^ fsw(v)) << 4) + (kk & 7) * 2) = (bf16)cvtpk_s(Sacc[j][i], 0.f); } }
        HBAR();
        pg8::bf16x8 qb[8];
#pragma unroll
        for (int ks = 0; ks < 8; ++ks) qb[ks] = rowfrag(stg + H_QT, 32 * tt + r, ks, hh);
        pg8::bf16x8 vf[2][2];
        hgrn_vfrags(stg, vf, vt, hh, tq, tp, tblk);
        f32x16 O;
#pragma unroll
        for (int i = 0; i < 16; ++i) O[i] = 0.f;
#pragma unroll
        for (int ks = 0; ks < 8; ++ks) O = MFMA32(rowfrag(lds + H_ST, 32 * vt + r, ks, hh), qb[ks], O);
#pragma unroll
        for (int st = 0; st < 2; ++st) {
            if (st <= tt) {
                f32x16 X;
#pragma unroll
                for (int i = 0; i < 16; ++i) X[i] = 0.f;
#pragma unroll
                for (int ks = 0; ks < 8; ++ks) X = MFMA32(rowfrag(stg + H_KH, 32 * st + r, ks, hh), qb[ks], X);
                if (st == tt) {
#pragma unroll
                    for (int i = 0; i < 16; ++i) X[i] = (crow(i, hh) <= r) ? X[i] : 0.f;
                }
#pragma unroll
                for (int s_ = 0; s_ < 2; ++s_) O = MFMA32(vf[st][s_], pack_step(X, s_), O);
            }
        }
        if (c < 3) hgrn_update(stg, Sacc, vf, tt, hh, tq, tp, tblk);
        HBAR();
        { float ss = 0.f;
#pragma unroll
            for (int i = 0; i < 16; ++i) ss += O[i] * O[i];
            ss += __shfl_xor(ss, 32);
            const int t = 32 * tt + r;
#pragma unroll
            for (int g4 = 0; g4 < 4; ++g4) { const int c16 = (32 * vt + 8 * g4 + 4 * hh) >> 2;
                *(LAS f32x4*)(lds + H_ST + t * 512 + ((c16 ^ (t & 31)) << 4)) = (f32x4){O[4 * g4], O[4 * g4 + 1], O[4 * g4 + 2], O[4 * g4 + 3]}; }
            if (hh == 0) ((LAS float*)(lds + H_PSS))[vt * 64 + t] = ss; }
        HBAR();
        { const int t = nt_, v0 = nv0;
            const LAS float* PSS = (const LAS float*)(lds + H_PSS);
            const float ss = (PSS[t] + PSS[64 + t]) + (PSS[128 + t] + PSS[192 + t]);
            const float rstd = __builtin_amdgcn_rsqf(ss * (1.0f / 128.0f) + EPS);
            bf16* yp = YB + nrow * 1024 + 512 + h * 128 + v0;
#pragma unroll
            for (int q8 = 0; q8 < 2; ++q8) {
                float gv[8], ov[8]; unpack8(q8 ? gq1 : gq0, gv);
                const int ca = (v0 + 8 * q8) >> 2;
                const f32x4 oa = *(const LAS f32x4*)(lds + H_ST + t * 512 + ((ca ^ (t & 31)) << 4)), ob = *(const LAS f32x4*)(lds + H_ST + t * 512 + (((ca + 1) ^ (t & 31)) << 4));
                const f32x4 na = *(const LAS f32x4*)(lds + H_PSS + 1024 + (v0 + 8 * q8) * 4), nb = *(const LAS f32x4*)(lds + H_PSS + 1024 + (v0 + 8 * q8 + 4) * 4);
#pragma unroll
                for (int i = 0; i < 4; ++i) { ov[i] = oa[i] * rstd * na[i] * gv[i]; ov[4 + i] = ob[i] * rstd * nb[i] * gv[4 + i]; }
                *(v4u*)(yp + 8 * q8) = pack8(ov);
            }
        }
        asm volatile("s_waitcnt vmcnt(2)" ::: "memory"); HBAR();
    }
}

__global__ void __launch_bounds__(NTHR, 2) fwd_kernel(Args args) {
    extern __shared__ __attribute__((aligned(16))) unsigned char lds_raw[];
    LAS unsigned char* lds = (LAS unsigned char*)lds_raw;
    volatile LAS unsigned* MISC = (volatile LAS unsigned*)(lds + MISC_OFF);
    const int tid = threadIdx.x, lane = tid & 63, wave = __builtin_amdgcn_readfirstlane(tid >> 6);
    const int G = gridDim.x, bx = blockIdx.x;
    unsigned char* ws = args.ws;
    gu32* ctl = (gu32*)(ws + WS_CTL);
    const float* x = args.in[0]; const float* p = args.in[1]; const float* norm_mix = args.in[2]; const float* w_in = args.in[3]; const float* hg_lb = args.in[4]; const float* hg_norm = args.in[5];
    const float* w_a_up = args.in[6]; const float* w_b_up = args.in[7]; const float* w_out = args.in[8]; const float* norm_ffn = args.in[9]; const float* w_gu = args.in[10]; const float* w_down = args.in[11];
    const float* norm_ple = args.in[12]; const float* w_pe = args.in[13]; const float* w_pg = args.in[14]; const float* norm_final = args.in[15];
    float* out = args.out;
    bf16* WIN = (bf16*)(ws + WS_WIN); bf16* WGU = (bf16*)(ws + WS_WGU); bf16* WDN = (bf16*)(ws + WS_WDN); bf16* WOUT = (bf16*)(ws + WS_WOUT); bf16* WPG = (bf16*)(ws + WS_WPG);
    bf16* WA = (bf16*)(ws + WS_WA); bf16* WB = (bf16*)(ws + WS_WB); bf16* WPE = (bf16*)(ws + WS_WPE);
    bf16* PB = (bf16*)(ws + WS_PB); bf16* XB = (bf16*)(ws + WS_XB); bf16* YA = (bf16*)(ws + WS_YA); bf16* YB = (bf16*)(ws + WS_YB);
    bf16* ATT = (bf16*)(ws + WS_ATT); bf16* HG = (bf16*)(ws + WS_HG); bf16* GT = (bf16*)(ws + WS_GT);
    float* LSEB = (float*)(ws + WS_LSE);
    float* EST = (float*)(ws + WS_EST); float* DSEG = (float*)(ws + WS_DSEG);
    float* DCH = (float*)(ws + WS_DCH);
    bf16* MRG = ATT; bf16* X1B = HG; bf16* HID = GT; bf16* X2B = ATT; bf16* PE = XB; bf16* X3B = HG;
    float* SS1 = (float*)(ctl + CW_SS1); float* SS2 = (float*)(ctl + CW_SS2); float* SS3 = (float*)(ctl + CW_SS3);

    for (int u = tid; u < (LDS_BYTES - LDSCTL_OFF) / 4; u += NTHR) ((LAS unsigned*)(lds + LDSCTL_OFF))[u] = 0u;
    __syncthreads();
    XcdBarrier bar = xcd_barrier_post((unsigned*)(ctl + CW_BAR), MISC + 8);

    {
        LAS float* scr = (LAS float*)(lds + RING_OFF + wave * 16384);
        const int gw = bx * NWAVES + wave, NGW = G * NWAVES;
        constexpr int I_IN = (D / 64) * (NIN / 32), I_GU = I_IN, I_DN = (FF / 64) * (D / 32), I_SQ = (D / 64) * (D / 32), I_AB = (512 / 64) * (D / 32), I_PE = (PLE / 64) * (D / 32);
        constexpr int NITEMS = I_IN + I_GU + I_DN + 2 * I_SQ + 2 * I_AB + I_PE;
        for (int it = gw; it < NITEMS; it += NGW) {
            int r = it;
            if (r < I_IN) { p0_transpose_item(w_in, D, NIN, norm_mix, WIN, 2, scr, r, lane); continue; } r -= I_IN;
            if (r < I_GU) { p0_transpose_item(w_gu, D, NIN, norm_ffn, WGU, 1, scr, r, lane); continue; } r -= I_GU;
            if (r < I_DN) { p0_transpose_item(w_down, FF, D, nullptr, WDN, 0, scr, r, lane); continue; } r -= I_DN;
            if (r < I_SQ) { p0_transpose_item(w_out, D, D, nullptr, WOUT, 0, scr, r, lane); continue; } r -= I_SQ;
            if (r < I_SQ) { p0_transpose_item(w_pg, D, D, norm_ple, WPG, 0, scr, r, lane); continue; } r -= I_SQ;
            if (r < I_AB) { p0_transpose_item(w_a_up, 512, D, nullptr, WA, 0, scr, r, lane, 1024, 0); continue; } r -= I_AB;
            if (r < I_AB) { p0_transpose_item(w_b_up, 512, D, nullptr, WA, 0, scr, r, lane, 1024, 512); continue; } r -= I_AB;
            p0_transpose_item(w_pe, PLE, D, nullptr, WPE, 0, scr, r, lane);
        }
        for (int m0 = 4 * gw; m0 < M; m0 += 4 * NGW) {
            f32x4 v[4][4], pv[4];
#pragma unroll
            for (int rr = 0; rr < 4; ++rr) {
                const GAS f32x4* xr = (const GAS f32x4*)(x + (size_t)(m0 + rr) * D) + lane;
#pragma unroll
                for (int j = 0; j < 4; ++j) v[rr][j] = xr[64 * j];
                pv[rr] = ((const GAS f32x4*)(p + (size_t)(m0 + rr) * PLE))[lane];
            }
#pragma unroll
            for (int rr = 0; rr < 4; ++rr) {
                float s = 0.f;
#pragma unroll
                for (int j = 0; j < 4; ++j) s += (v[rr][j].x * v[rr][j].x + v[rr][j].y * v[rr][j].y) + (v[rr][j].z * v[rr][j].z + v[rr][j].w * v[rr][j].w);
                s = wave_sum(s);
                const float rs = __builtin_amdgcn_rsqf(s * (1.0f / D) + EPS);
                GAS v2u* o8 = (GAS v2u*)(XB + (size_t)(m0 + rr) * D) + lane;
#pragma unroll
                for (int j = 0; j < 4; ++j) { v2u w; w.x = pg8::cvt_pk_bf16(v[rr][j].x * rs, v[rr][j].y * rs); w.y = pg8::cvt_pk_bf16(v[rr][j].z * rs, v[rr][j].w * rs); o8[64 * j] = w; }
                v2u w; w.x = pg8::cvt_pk_bf16(pv[rr].x, pv[rr].y); w.y = pg8::cvt_pk_bf16(pv[rr].z, pv[rr].w);
                ((GAS v2u*)(PB + (size_t)(m0 + rr) * PLE))[lane] = w;
            }
        }
    }
    xcd_barrier(bar);

    {
        pg8::Gemm g{XB, WIN, M, NIN, D}; pg8::StaticOrder S; S.init(M, NIN, G, bx);
        Epi<1> E{}; E.a.att = ATT; E.a.hg = HG; E.a.g = GT; E.a.hg_lb = hg_lb; E.a.dch = DCH;
        pg8::gemm_phase<Epi<1>, pg8::StaticOrder, true, true>(lds + RING_OFF, g, S, E);
    }
    xcd_barrier(bar);

#define HG_ALL() do { hgrn_passA(lds, HG, DCH, EST, DSEG, bx, G, tid); xcd_barrier(bar); hgrn_passB(EST, DSEG, bx, G, tid); xcd_barrier(bar); \
    hgrn_passC(lds, HG, DCH, hg_norm, EST, YB, bx, G, tid); } while (0)
    HG_ALL();
    for (int u = bx; u < 256; u += G) attn16_unit(lds + RING_OFF, ATT, YA, LSEB, u >> 4, (u >> 1) & 7, u & 1, tid);
    __syncthreads();
    for (int u = tid; u < (LDS_BYTES - LDSCTL_OFF) / 4; u += NTHR) ((LAS unsigned*)(lds + LDSCTL_OFF))[u] = 0u;
    __syncthreads();
    xcd_barrier(bar);

    {
        pg8::SplitOrder S; S.init(M, D, G, bx);
        pg8::Gemm g{YA, WA, M, D, 512, 1024}; Epi<2> E{}; E.a.gate = GT; E.a.ob = MRG;
        pg8::gemm_phase<Epi<2>, pg8::SplitOrder, true, true>(lds + RING_OFF, g, S, E);
    }
    xcd_barrier(bar);

    {
        pg8::Gemm g{MRG, WOUT, M, D, D}; pg8::StaticOrder S; S.init(M, D, G, bx);
        Epi<4> E{}; E.a.xres = x; E.a.ob = X1B; E.a.ss = SS1;
        pg8::gemm_phase<Epi<4>, pg8::StaticOrder, true, true>(lds + RING_OFF, g, S, E);
    }
    xcd_barrier(bar);

    {
        pg8::Gemm g{X1B, WGU, M, NIN, D}; pg8::StaticOrder S; S.init(M, NIN, G, bx);
        Epi<5> E{}; E.a.rs = SS1; E.a.ob = HID;
        pg8::gemm_phase<Epi<5>, pg8::StaticOrder, true, true>(lds + RING_OFF, g, S, E);
    }
    xcd_barrier(bar);

    {
        pg8::Gemm g{HID, WDN, M, D, FF}; pg8::StaticOrder S; S.init(M, D, G, bx);
        Epi<6> E{}; E.a.xrb = X1B; E.a.ob = X2B; E.a.ss = SS2;
        pg8::gemm_phase<Epi<6>, pg8::StaticOrder, true, true>(lds + RING_OFF, g, S, E);
    }
    xcd_barrier(bar);

    {
        pg8::StaticOrder S; S.init(M, D, G, bx);
        { pg8::Gemm g{PB, WPE, M, D, PLE}; Epi<7> E{}; E.a.ob = PE; pg8::gemm_phase<Epi<7>, pg8::StaticOrder, true, true>(lds + RING_OFF, g, S, E); }
        { pg8::Gemm g{X2B, WPG, M, D, D}; Epi<8> E{}; E.a.rs = SS2; E.a.gate = PE; E.a.xrb = X2B; E.a.ob = X3B; E.a.ss = SS3; pg8::gemm_phase<Epi<8>, pg8::StaticOrder, true, true>(lds + RING_OFF, g, S, E); }
    }
    xcd_barrier(bar);

    {
        const int gw = bx * NWAVES + wave, NGW = G * NWAVES;
        const bool bad = __hip_atomic_load(ctl + CW_BAR + XB_TMO, RLX_AGENT) != 0u;
        for (int m0 = 4 * gw; m0 < M; m0 += 4 * NGW) {
            v4u xin[4][2]; float rr_[4];
#pragma unroll
            for (int q = 0; q < 4; ++q) { const v4u* xr = (const v4u*)(X3B + (size_t)(m0 + q) * D) + lane; xin[q][0] = xr[0]; xin[q][1] = xr[64]; rr_[q] = SS3[m0 + q]; }
#pragma unroll
            for (int q = 0; q < 4; ++q) {
                float r = __builtin_amdgcn_rsqf(rr_[q] * (1.0f / D) + EPS);
                if (bad) r = __builtin_nanf("");
                f32x4* orow = (f32x4*)(out + (size_t)(m0 + q) * D);
#pragma unroll
                for (int j = 0; j < 2; ++j) {
                    float v[8]; unpack8(xin[q][j], v);
                    const int c0 = 512 * j + 8 * lane;
                    const f32x4 g0 = *(const f32x4*)(norm_final + c0), g1 = *(const f32x4*)(norm_final + c0 + 4);
                    orow[(c0 >> 2)] = (f32x4){v[0] * r * g0[0], v[1] * r * g0[1], v[2] * r * g0[2], v[3] * r * g0[3]};
                    orow[(c0 >> 2) + 1] = (f32x4){v[4] * r * g1[0], v[5] * r * g1[1], v[6] * r * g1[2], v[7] * r * g1[3]};
                }
            }
        }
    }
}

extern "C" void kernel_launch(void* const* d_in, const int* in_sizes, int n_in, void* d_out, int out_size, void* d_ws, size_t ws_size, hipStream_t stream) {
    static int grid = 0;
    if (grid == 0) {
        if (n_in != 16 || out_size != M * D || ws_size < WS_END) { fprintf(stderr, "kernel_launch: unexpected shapes (n_in %d out %d ws %zu)\n", n_in, out_size, ws_size); grid = -1; return; }
        int dev = 0, cus = 0, per_cu = 0;
        if (hipGetDevice(&dev) != hipSuccess || hipDeviceGetAttribute(&cus, hipDeviceAttributeMultiprocessorCount, dev) != hipSuccess) { grid = -1; return; }
        if (hipFuncSetAttribute((const void*)fwd_kernel, hipFuncAttributeMaxDynamicSharedMemorySize, LDS_BYTES) != hipSuccess) { fprintf(stderr, "kernel_launch: hipFuncSetAttribute failed\n"); grid = -1; return; }
        if (hipOccupancyMaxActiveBlocksPerMultiprocessor(&per_cu, (const void*)fwd_kernel, NTHR, LDS_BYTES) != hipSuccess || per_cu < 1) fprintf(stderr, "kernel_launch: occupancy query says %d\n", per_cu);
        (void)hipGetLastError();
        grid = cus;
    }
    if (grid < 0) return;
    (void)hipMemsetAsync((char*)d_ws + WS_CTL, 0, CTL_ZERO_BYTES, stream);
    Args a{};
    for (int i = 0; i < 16; ++i) a.in[i] = (const float*)d_in[i];
    a.out = (float*)d_out; a.ws = (unsigned char*)d_ws;
    hipLaunchKernelGGL(fwd_kernel, dim3(grid), dim3(NTHR), LDS_BYTES, stream, a);
}
```

```cpp
#include <hip/hip_runtime.h>
#include <cstdio>
#include <cstdint>
namespace pg8 {
#define PG8_LAS __attribute__((address_space(3)))
typedef unsigned short bf16_t;
typedef short bf16x8 __attribute__((ext_vector_type(8)));
typedef float f32x4 __attribute__((ext_vector_type(4)));
typedef unsigned u32x4 __attribute__((ext_vector_type(4)));
constexpr int BM = 256, BK = 64, HALF = 128, HTB = HALF * BK * 2  , STAGE_BYTES = 8 * HTB, NXCD = 8, WGM = 8;

__host__ __device__ __forceinline__ int lds_byte(int r, int c) { const int st = (r >> 4) * 2 + (c >> 5), rr = r & 15, cc = c & 31, ob = rr * 64 + cc * 2; return st * 1024 + (ob ^ (((ob >> 9) & 1) << 5)); }
__host__ __device__ __forceinline__ void stage_rc(int b, int& R, int& C) { const int st = b / 1024, sb = b % 1024, swz = sb ^ (((sb >> 9) & 1) << 5); R = (st >> 1) * 16 + swz / 64; C = (st & 1) * 32 + (swz % 64) / 2; }
__host__ __device__ __forceinline__ int perm32(int rho) { const int n = rho >> 4, i = rho & 15; return 8 * (i >> 2) + 4 * n + (i & 3); }

struct Unit { int pm, pn, ks; };
struct Gemm { const bf16_t* A; const bf16_t* Bt; int M, N, K, ld; };

struct StaticOrder {
    int nM, nN, nwg, G, c;
    __host__ __device__ void init(int M, int N, int G_, int c_) { nM = M / BM; nN = N / BM; nwg = nM * nN; G = G_; c = c_; }
    __host__ __device__ bool next(int i, Unit& u) const {
        const long L = (long)i * G + c; if (L >= nwg) return false;
        int wgid = (int)L; { const int q = nwg / NXCD, r = nwg % NXCD, xcd = wgid % NXCD, off = wgid / NXCD; wgid = (xcd < r ? xcd * (q + 1) : r * (q + 1) + (xcd - r) * q) + off; }
        const int nig = WGM * nN, gid = wgid / nig, fm = gid * WGM, gsz = (nM - fm) < WGM ? (nM - fm) : WGM;
        u.pm = fm + ((wgid % nig) % gsz); u.pn = (wgid % nig) / gsz; u.ks = 0; return true;
    }
    __device__ __forceinline__ void a_ready(const Unit&) const {}
    __device__ __forceinline__ void done(const Unit&) const {}
};
struct SplitOrder : StaticOrder {
    __host__ __device__ bool next(int i, Unit& u) const { if (!StaticOrder::next(i >> 1, u)) return false; u.ks = i & 1; return true; }
};

__device__ __forceinline__ unsigned cvt_pk_bf16(float lo, float hi) { unsigned r; asm volatile("v_cvt_pk_bf16_f32 %0, %1, %2" : "=v"(r) : "v"(lo), "v"(hi)); return r; }
template <class Epi, class Sched, bool ALIGN_EPI = false, bool SP2 = false>
__device__ __forceinline__ void gemm_phase(PG8_LAS unsigned char* lds, const Gemm g, const Sched& S, const Epi& E) {
    int tid_ = threadIdx.x; asm volatile("" : "+v"(tid_));
    const int tid = tid_, wid = __builtin_amdgcn_readfirstlane(tid >> 6), lane = tid & 63, wr = wid >> 2, wc = wid & 3, fr = lane & 15, fq = lane >> 4;
    const int K = g.K, nt = K / BK, ld = g.ld ? g.ld : K;
    unsigned voffA[2], voffB[2];
#pragma unroll
    for (int i = 0; i < 2; ++i) { int R, C; stage_rc(tid * 16 + i * 8192, R, C); const int Rb = Epi::PERM ? ((R & ~31) + perm32(R & 31)) : R;
        voffA[i] = (unsigned)(R * ld + C) * 2u; voffB[i] = (unsigned)(Rb * ld + C) * 2u; }
    const size_t kstep = (size_t)(BK * 2);
    const size_t hstep = (size_t)HALF * ld * 2;
    const size_t tstep = 2 * hstep;
    const unsigned ldsw = (unsigned)wid * 1024u;
    const int aoff = lds_byte(wr * 64 + fr, fq * 8), boff = lds_byte(wc * 32 + fr, fq * 8);
#define PG8_SA(b, h) (((b) * 2 + (h)) * HTB)
#define PG8_SB(b, h) ((4 + (b) * 2 + (h)) * HTB)
#define PG8_STAGE(bufoff, gbase, voff) do { _Pragma("unroll") for (int _i = 0; _i < 2; ++_i) \
        __builtin_amdgcn_global_load_lds((const unsigned*)((const char*)(gbase) + (voff)[_i]), (PG8_LAS unsigned*)(lds + (bufoff) + ldsw + _i * 8192), 16, 0, 0); } while (0)
#define PG8_LDA(dst, b, h) do { _Pragma("unroll") for (int m = 0; m < 4; ++m) _Pragma("unroll") for (int k = 0; k < 2; ++k) dst[m][k] = *(const PG8_LAS bf16x8*)(lds + PG8_SA(b, h) + aoff + m * 2048 + k * 1024); } while (0)
#define PG8_LDB(dst, b, h) do { _Pragma("unroll") for (int n = 0; n < 2; ++n) _Pragma("unroll") for (int k = 0; k < 2; ++k) dst[n][k] = *(const PG8_LAS bf16x8*)(lds + PG8_SB(b, h) + boff + n * 2048 + k * 1024); } while (0)
#define PG8_MMA(ai, bj, At, Bt) do { __builtin_amdgcn_s_setprio(1); _Pragma("unroll") for (int m = 0; m < 4; ++m) _Pragma("unroll") for (int n = 0; n < 2; ++n) _Pragma("unroll") for (int k = 0; k < 2; ++k) \
        acc[ai][bj][m][n] = __builtin_amdgcn_mfma_f32_16x16x32_bf16(Bt[n][k], At[m][k], acc[ai][bj][m][n], 0, 0, 0); __builtin_amdgcn_s_setprio(0); } while (0)
#define PG8_WAIT_V(n) asm volatile("s_waitcnt vmcnt(" #n ")" ::: "memory")
#define PG8_WAIT_L(n) asm volatile("s_waitcnt lgkmcnt(" #n ")" ::: "memory")
#define PG8_BAR __builtin_amdgcn_s_barrier()
#define PG8_SCHED __builtin_amdgcn_sched_barrier(0)
    Unit cur, nxt; int ui = 0;
    if (!S.next(0, cur)) return;
    f32x4 acc[2][2][4][2];
#pragma unroll
    for (int a = 0; a < 2; ++a)
#pragma unroll
        for (int b = 0; b < 2; ++b)
#pragma unroll
            for (int m = 0; m < 4; ++m)
#pragma unroll
                for (int n = 0; n < 2; ++n) acc[a][b][m][n] = (f32x4){0.f, 0.f, 0.f, 0.f};
    bf16x8 At[4][2], B0[2][2], B1[2][2];
    const char* cA = (const char*)g.A + (size_t)cur.pm * tstep + (size_t)cur.ks * K * 2; const char* cB = (const char*)g.Bt + (size_t)cur.pn * tstep + (size_t)cur.ks * K * 2;
    S.a_ready(cur);
    if constexpr (SP2) {
        PG8_STAGE(PG8_SB(0, 0), cB, voffB); PG8_STAGE(PG8_SB(0, 1), cB + hstep, voffB); PG8_STAGE(PG8_SA(0, 0), cA, voffA); PG8_STAGE(PG8_SA(0, 1), cA + hstep, voffA);
        if (wr == 1) PG8_BAR;
        PG8_WAIT_V(2); PG8_BAR;
        PG8_STAGE(PG8_SB(1, 0), cB + kstep, voffB); PG8_STAGE(PG8_SA(1, 0), cA + kstep, voffA); PG8_STAGE(PG8_SB(1, 1), cB + hstep + kstep, voffB);
        PG8_WAIT_V(6); PG8_BAR;
    } else {
        PG8_STAGE(PG8_SB(0, 0), cB, voffB); PG8_STAGE(PG8_SA(0, 0), cA, voffA); PG8_STAGE(PG8_SB(0, 1), cB + hstep, voffB); PG8_STAGE(PG8_SA(0, 1), cA + hstep, voffA);
        if (wr == 1) PG8_BAR;
        PG8_WAIT_V(4); PG8_BAR;
        PG8_STAGE(PG8_SB(1, 0), cB + kstep, voffB); PG8_STAGE(PG8_SA(1, 0), cA + kstep, voffA); PG8_STAGE(PG8_SB(1, 1), cB + hstep + kstep, voffB);
        PG8_WAIT_V(6); PG8_BAR;
    }
    for (;;) {
        const bool has_next = S.next(ui + 1, nxt);
        const char* nA = has_next ? (const char*)g.A + (size_t)nxt.pm * tstep + (size_t)nxt.ks * K * 2 : cA; const char* nB = has_next ? (const char*)g.Bt + (size_t)nxt.pn * tstep + (size_t)nxt.ks * K * 2 : cB;
#pragma nounroll
        for (int t = 0; t < nt; t += 2) {
            const bool last = (t == nt - 2);
            const char* a1 = cA + (size_t)(t + 1) * kstep;
            const char* a2 = last ? nA : cA + (size_t)(t + 2) * kstep; const char* b2 = last ? nB : cB + (size_t)(t + 2) * kstep;
            const char* a3 = a2 + kstep; const char* b3 = b2 + kstep;
            if (last && has_next) S.a_ready(nxt);
            if constexpr (SP2) {
            PG8_LDB(B0, 0, 0); PG8_LDB(B1, 0, 1); PG8_SCHED; PG8_LDA(At, 0, 0); PG8_STAGE(PG8_SA(1, 1), a1 + hstep, voffA);
            PG8_WAIT_V(8); PG8_WAIT_L(0); PG8_BAR; PG8_MMA(0, 0, At, B0); PG8_MMA(0, 1, At, B1); PG8_BAR; PG8_SCHED;
            PG8_LDA(At, 0, 1); PG8_STAGE(PG8_SB(0, 0), b2, voffB); PG8_STAGE(PG8_SB(0, 1), b2 + hstep, voffB); PG8_STAGE(PG8_SA(0, 0), a2, voffA);
            PG8_WAIT_V(8); PG8_WAIT_L(0); PG8_BAR; PG8_MMA(1, 0, At, B0); PG8_MMA(1, 1, At, B1); PG8_BAR; PG8_SCHED;
            PG8_LDB(B0, 1, 0); PG8_LDB(B1, 1, 1); PG8_SCHED; PG8_LDA(At, 1, 0); PG8_STAGE(PG8_SA(0, 1), a2 + hstep, voffA);
            PG8_WAIT_V(8); PG8_WAIT_L(0); PG8_BAR; PG8_MMA(0, 0, At, B0); PG8_MMA(0, 1, At, B1); PG8_BAR; PG8_SCHED;
            PG8_LDA(At, 1, 1); PG8_STAGE(PG8_SB(1, 0), b3, voffB); PG8_STAGE(PG8_SB(1, 1), b3 + hstep, voffB); PG8_STAGE(PG8_SA(1, 0), a3, voffA);
            PG8_WAIT_V(8); PG8_WAIT_L(0); PG8_BAR; PG8_MMA(1, 0, At, B0); PG8_MMA(1, 1, At, B1); PG8_BAR; PG8_SCHED;
            } else {
            PG8_LDB(B0, 0, 0); PG8_SCHED; PG8_LDA(At, 0, 0); PG8_STAGE(PG8_SA(1, 1), a1 + hstep, voffA);
            PG8_WAIT_L(8); PG8_BAR; PG8_WAIT_L(0); PG8_MMA(0, 0, At, B0); PG8_BAR; PG8_SCHED;
            PG8_LDB(B1, 0, 1); PG8_STAGE(PG8_SB(0, 0), b2, voffB);
            PG8_BAR; PG8_WAIT_L(0); PG8_MMA(0, 1, At, B1); PG8_BAR;
            PG8_LDA(At, 0, 1); PG8_STAGE(PG8_SA(0, 0), a2, voffA);
            PG8_BAR; PG8_WAIT_L(0); PG8_MMA(1, 0, At, B0); PG8_BAR; PG8_SCHED;
            PG8_STAGE(PG8_SB(0, 1), b2 + hstep, voffB);
            PG8_WAIT_V(6); PG8_BAR; PG8_MMA(1, 1, At, B1); PG8_BAR;
            PG8_LDB(B0, 1, 0); PG8_SCHED; PG8_LDA(At, 1, 0); PG8_STAGE(PG8_SA(0, 1), a2 + hstep, voffA);
            PG8_WAIT_L(8); PG8_BAR; PG8_WAIT_L(0); PG8_MMA(0, 0, At, B0); PG8_BAR; PG8_SCHED;
            PG8_LDB(B1, 1, 1); PG8_STAGE(PG8_SB(1, 0), b3, voffB);
            PG8_BAR; PG8_WAIT_L(0); PG8_MMA(0, 1, At, B1); PG8_BAR;
            PG8_LDA(At, 1, 1); PG8_STAGE(PG8_SA(1, 0), a3, voffA);
            PG8_BAR; PG8_WAIT_L(0); PG8_MMA(1, 0, At, B0); PG8_BAR; PG8_SCHED;
            PG8_STAGE(PG8_SB(1, 1), b3 + hstep, voffB);
            PG8_WAIT_V(6); PG8_BAR; PG8_MMA(1, 1, At, B1); PG8_BAR;
            }
        }
        if constexpr (ALIGN_EPI) { if (wr == 0) PG8_BAR; }
        bool keep_acc = false;
        if constexpr (Epi::KSPLIT) { if (cur.ks == 0) { E.mid(acc, cur, wr, wc, fr, fq); keep_acc = true; } }
        if constexpr (!Epi::AFTER_DRAIN) { if (!keep_acc) { E(acc, cur, wr, wc, fr, fq); S.done(cur); } }
        if (!has_next) break;
        if (!keep_acc)
#pragma unroll
        for (int a = 0; a < 2; ++a)
#pragma unroll
            for (int b = 0; b < 2; ++b)
#pragma unroll
                for (int m = 0; m < 4; ++m)
#pragma unroll
                    for (int n = 0; n < 2; ++n) acc[a][b][m][n] = (f32x4){0.f, 0.f, 0.f, 0.f};
        cur = nxt; cA = nA; cB = nB; ++ui;
        if constexpr (ALIGN_EPI) { if (wr == 1) PG8_BAR; }
    }
    PG8_WAIT_V(0);
    if constexpr (!ALIGN_EPI) { if (wr == 0) PG8_BAR; }
    PG8_BAR;
    if constexpr (Epi::AFTER_DRAIN) { E.fused(acc, cur, wr, wc, fr, fq, lds, wid, lane); S.done(cur); }
#undef PG8_SA
#undef PG8_SB
#undef PG8_STAGE
#undef PG8_LDA
#undef PG8_LDB
#undef PG8_MMA
#undef PG8_WAIT_V
#undef PG8_WAIT_L
#undef PG8_BAR
#undef PG8_SCHED
}
}
constexpr int BATCH = 16, SEQ = 4096, D = 1024, M = BATCH * SEQ;
constexpr int NIN = 5632, FF = 2816, PLE = 256;
constexpr int ATTW = 1536, HGW = 2048, GW = 2048;
constexpr float EPS = 1e-6f;
constexpr float QSCALE = 0.125f * 1.4426950408889634f;
constexpr int NWAVES = 8, NTHR = NWAVES * 64;

constexpr size_t MiB = 1u << 20;
constexpr size_t WS_CTL = 0, CTL_ZERO_BYTES = 1 * MiB;
constexpr size_t WS_WIN = 2 * MiB, WS_WGU = 13 * MiB, WS_WDN = 24 * MiB, WS_WOUT = 30 * MiB, WS_WPG = 32 * MiB, WS_WA = 34 * MiB, WS_WB = 35 * MiB, WS_WPE = 36 * MiB;
constexpr size_t WS_RSTD0 = 37 * MiB;
constexpr size_t WS_LSE = 40 * MiB;
constexpr size_t WS_PB = 48 * MiB;
constexpr size_t WS_XB = 80 * MiB;
constexpr size_t WS_YA = 80 * MiB, WS_YB = 80 * MiB;
constexpr size_t WS_ATT = 208 * MiB;
constexpr size_t WS_HG = 400 * MiB;
constexpr size_t WS_GT = 656 * MiB;
constexpr size_t WS_EST = 912 * MiB;
constexpr size_t WS_DCH = 45 * MiB;
constexpr size_t WS_DSEG = 44 * MiB;
constexpr size_t WS_END = 1024 * MiB;
constexpr int CW_BAR = 4096;
constexpr int CW_SS1 = 65536, CW_SS2 = 2 * 65536, CW_SS3 = 3 * 65536;

constexpr int RING_OFF = 0, RING_BYTES = 131072;
constexpr int LDSCTL_OFF = RING_BYTES, MISC_OFF = LDSCTL_OFF + 320;
constexpr int LDS_BYTES = 163840;

#define GAS __attribute__((address_space(1)))
#define LAS __attribute__((address_space(3)))
#define DI __device__ __forceinline__
typedef unsigned short bf16;
typedef unsigned v4u __attribute__((ext_vector_type(4)));
typedef unsigned v2u __attribute__((ext_vector_type(2)));
typedef float f32x4 __attribute__((ext_vector_type(4)));
typedef GAS unsigned gu32;
#define RLX_AGENT __ATOMIC_RELAXED, __HIP_MEMORY_SCOPE_AGENT
#define LDS_WAIT() asm volatile("s_waitcnt lgkmcnt(0)" ::: "memory")
#define VM_WAIT() asm volatile("s_waitcnt vmcnt(0)" ::: "memory")
DI float bflo(unsigned u) { return __builtin_bit_cast(float, u << 16); }
DI float bfhi(unsigned u) { return __builtin_bit_cast(float, u & 0xffff0000u); }
DI float bf2f(bf16 b) { return __builtin_bit_cast(float, (unsigned)b << 16); }
DI float sigmoidf_(float v) { return __builtin_amdgcn_rcpf(1.0f + __expf(-v)); }

#define XB_TMO      128
#define XB_XCNT(j)  (256  + 64 * (j))
#define XB_XSUB(j)  (1280 + 64 * (j))
#define XB_XGEN(j)  (2304 + 64 * (j))
#define XB_TOP      3328
#define XB_TOPGEN   3392
#define XCD_BAR_WORDS 3456
#define XB_SPIN_CAP (1u << 18)

__device__ __forceinline__ unsigned xb_ld(unsigned* p)              { return __hip_atomic_load(p, __ATOMIC_RELAXED, __HIP_MEMORY_SCOPE_AGENT); }
__device__ __forceinline__ unsigned xb_add(unsigned* p, unsigned v) { return __hip_atomic_fetch_add(p, v, __ATOMIC_RELAXED, __HIP_MEMORY_SCOPE_AGENT); }
__device__ __forceinline__ unsigned xb_xcc_id() { return (unsigned)__builtin_amdgcn_s_getreg((3 << 11) | 20) & 0xFu; }
#define XB_SPIN(cond, bar) do { unsigned _sp = 0; while (cond) { __builtin_amdgcn_s_sleep(1); \
    if ((++_sp & 255u) == 0u) { if (xb_ld(&(bar)[XB_TMO])) break; if (_sp > XB_SPIN_CAP) { atomicAdd(&(bar)[XB_TMO], 1u); break; } } } } while (0)

struct XcdBarrier {
    unsigned* bar; unsigned x;
    volatile LAS unsigned* st;
};

__device__ __forceinline__ XcdBarrier xcd_barrier_post(unsigned* bar, volatile LAS unsigned* st) {
    XcdBarrier b; b.bar = bar; b.x = xb_xcc_id(); b.st = st;
    if (threadIdx.x == 0) (void)xb_add(&bar[XB_XCNT(b.x)], 1u);
    return b;
}
__device__ __forceinline__ void xcd_barrier_complete(unsigned* bar, unsigned x, unsigned& nloc, unsigned& nx) {
    const unsigned G = gridDim.x * gridDim.y * gridDim.z;
    unsigned sum, cnt, mine, sp = 0u;
    for (;;) {
        sum = 0u; cnt = 0u; mine = 0u;
#pragma unroll
        for (unsigned j = 0; j < 16; ++j) { const unsigned c = xb_ld(&bar[XB_XCNT(j)]); sum += c; cnt += (c > 0u) ? 1u : 0u; mine = (j == x) ? c : mine; }
        if (sum == G) break;
        __builtin_amdgcn_s_sleep(1);
        if ((++sp & 255u) == 0u) { if (xb_ld(&bar[XB_TMO])) break; if (sp > XB_SPIN_CAP) { atomicAdd(&bar[XB_TMO], 1u); break; } }
    }
    nloc = mine > 0u ? mine : 1u; nx = cnt > 0u ? cnt : 1u;
}

__device__ __forceinline__ void xcd_barrier(const XcdBarrier& b) {
    asm volatile("s_waitcnt vmcnt(0)" ::: "memory");
    __syncthreads();
    if (threadIdx.x == 0) {
        unsigned* bar = b.bar;
        __builtin_amdgcn_s_waitcnt(0);
        unsigned nloc = b.st[0], nx = b.st[1];
        if (nloc == 0u) { xcd_barrier_complete(bar, b.x, nloc, nx); b.st[0] = nloc; b.st[1] = nx; }
        const unsigned old = xb_add(&bar[XB_XSUB(b.x)], 1u);
        const unsigned gen = old / nloc;
        if (old + 1u == (gen + 1u) * nloc) {
            __builtin_amdgcn_fence(__ATOMIC_RELEASE, "agent");
            asm volatile("s_waitcnt vmcnt(0)" ::: "memory");
            const unsigned og = xb_add(&bar[XB_TOP], 1u);
            const unsigned tg = og / nx;
            if (og + 1u == (tg + 1u) * nx) xb_add(&bar[XB_TOPGEN], 1u);
            else XB_SPIN(xb_ld(&bar[XB_TOPGEN]) == tg, bar);
            __builtin_amdgcn_fence(__ATOMIC_ACQUIRE, "agent");
            xb_add(&bar[XB_XGEN(b.x)], 1u);
            asm volatile("s_waitcnt vmcnt(0)" ::: "memory");
        } else {
            XB_SPIN(xb_ld(&bar[XB_XGEN(b.x)]) == gen, bar);
            __builtin_amdgcn_fence(__ATOMIC_ACQUIRE, "agent");
            asm volatile("s_waitcnt vmcnt(0)" ::: "memory");
        }
    }
    __syncthreads();
}

struct EpiArgs {
    const float* rs;
    float* ss;
    const float* xres;
    const bf16* xrb;
    bf16* ob;
    const bf16* gate;
    bf16* att; bf16* hg; bf16* g;
    const float* hg_lb; float* dch;
};
DI void unpack8(const v4u q, float (&f)[8]) { f[0] = bflo(q.x); f[1] = bfhi(q.x); f[2] = bflo(q.y); f[3] = bfhi(q.y); f[4] = bflo(q.z); f[5] = bfhi(q.z); f[6] = bflo(q.w); f[7] = bfhi(q.w); }
DI v4u pack8(const float (&f)[8]) { v4u w; w.x = pg8::cvt_pk_bf16(f[0], f[1]); w.y = pg8::cvt_pk_bf16(f[2], f[3]); w.z = pg8::cvt_pk_bf16(f[4], f[5]); w.w = pg8::cvt_pk_bf16(f[6], f[7]); return w; }

#define ST16(p, v) (*(v4u*)(p) = (v))
template <int N> DI float row_shr(float v) { return __builtin_bit_cast(float, __builtin_amdgcn_update_dpp(0, __builtin_bit_cast(int, v), 0x110 + N, 0xf, 0xf, true)); }
DI float row_last(float v, int lane) { return __builtin_bit_cast(float, __builtin_amdgcn_ds_bpermute((lane | 15) << 2, __builtin_bit_cast(int, v))); }

template <int MODE> struct Epi {
    static constexpr bool PERM = true, AFTER_DRAIN = false;
    static constexpr bool KSPLIT = (MODE == 2);
    EpiArgs a;
    DI void mid(pg8::f32x4 (&acc)[2][2][4][2], const pg8::Unit& u, int wr, int wc, int fr, int fq) const {
        const bf16* gbase = a.gate + (size_t)(u.pm * 256 + wr * 64 + fr) * GW + u.pn * 256 + wc * 32 + 8 * fq;
#pragma unroll
        for (int ai = 0; ai < 2; ++ai)
#pragma unroll
            for (int m = 0; m < 4; ++m)
#pragma unroll
                for (int bj = 0; bj < 2; ++bj) {
                    const bf16* gp = gbase + (size_t)(ai * 128 + m * 16) * GW + bj * 128;
                    float ga[8], gb[8]; unpack8(*(const v4u*)gp, ga); unpack8(*(const v4u*)(gp + 1024), gb);
#pragma unroll
                    for (int i = 0; i < 4; ++i) { acc[ai][bj][m][0][i] *= ga[i] * __builtin_amdgcn_rcpf(fmaxf(gb[i], 1e-30f)); acc[ai][bj][m][1][i] *= ga[4 + i] * __builtin_amdgcn_rcpf(fmaxf(gb[4 + i], 1e-30f)); }
                }
    }
    DI void hgrn_tile(const pg8::f32x4 (&acc)[2][2][4][2], const pg8::Unit& u, int wr, int wc, int fr, int fq) const {
        const int h = u.pn - 6, chb = wc * 32 + 8 * fq, lane = fq * 16 + fr;
        float lbv[8];
        { const f32x4 a0 = *(const f32x4*)(a.hg_lb + h * 128 + chb), a1 = *(const f32x4*)(a.hg_lb + h * 128 + chb + 4), b0 = *(const f32x4*)(a.hg_lb + 512 + h * 128 + chb), b1 = *(const f32x4*)(a.hg_lb + 512 + h * 128 + chb + 4);
#pragma unroll
            for (int i = 0; i < 4; ++i) { lbv[i] = 1.0f / (1.0f + __expf(b0[i] - a0[i])); lbv[4 + i] = 1.0f / (1.0f + __expf(b1[i] - a1[i])); } }
#pragma unroll
        for (int ai = 0; ai < 2; ++ai) {
            const int rowc = u.pm * 256 + ai * 128 + wr * 64;
#pragma unroll
            for (int n = 0; n < 2; ++n) {
                float qt[4][4], kh[4][4], dtot[4];
#pragma unroll
                for (int i = 0; i < 4; ++i) {
                    const float lb = lbv[4 * n + i];
                    float sc[4], kf[4], rt[4];
#pragma unroll
                    for (int m = 0; m < 4; ++m) {
                        const float f = lb + (1.0f - lb) * sigmoidf_(acc[ai][1][m][n][i]);
                        kf[m] = 1.0f - f;
                        float s = __logf(f);
                        s += row_shr<1>(s); s += row_shr<2>(s); s += row_shr<4>(s); s += row_shr<8>(s);
                        sc[m] = s; rt[m] = row_last(s, lane);
                    }
                    const float tot = (rt[0] + rt[1]) + (rt[2] + rt[3]);
                    float off = 0.f;
#pragma unroll
                    for (int m = 0; m < 4; ++m) { const float b = sc[m] + off; off += rt[m];
                        qt[m][i] = acc[ai][0][m][n][i] * __expf(fminf(b - tot, 80.0f));
                        kh[m][i] = kf[m] * __expf(tot - b); }
                    dtot[i] = __expf(tot);
                }
#pragma unroll
                for (int m = 0; m < 4; ++m) { const int row = rowc + m * 16 + fr; bf16* dst = a.hg + ((size_t)((row >> 12) * 4 + h) * SEQ + (row & (SEQ - 1))) * 128 + chb + 4 * n;
                    v2u wq, wk; wq.x = pg8::cvt_pk_bf16(qt[m][0], qt[m][1]); wq.y = pg8::cvt_pk_bf16(qt[m][2], qt[m][3]); wk.x = pg8::cvt_pk_bf16(kh[m][0], kh[m][1]); wk.y = pg8::cvt_pk_bf16(kh[m][2], kh[m][3]);
                    *(v2u*)dst = wq; *(v2u*)(dst + (size_t)M * 512) = wk; }
                if (fr == 0) { float* dp = a.dch + ((size_t)(rowc >> 6) * 4 + h) * 128 + chb + 4 * n;
                    *(f32x4*)dp = (f32x4){dtot[0], dtot[1], dtot[2], dtot[3]}; }
            }
        }
    }
    DI void operator()(const pg8::f32x4 (&acc)[2][2][4][2], const pg8::Unit& u, int wr, int wc, int fr, int fq) const {
        const int row0 = u.pm * 256 + wr * 64 + fr;
        const int colt = u.pn * 256 + wc * 32 + 8 * fq;
        int kind = 0;
        if (MODE == 1) kind = (u.pn < 2) ? 0 : (u.pn < 6) ? 1 : (u.pn < 10) ? 5 : (u.pn < 12) ? 2 : (u.pn < 14) ? 3 : 4;
        if constexpr (MODE == 1) { if (kind == 5) { hgrn_tile(acc, u, wr, wc, fr, fq); return; } }
#pragma unroll
        for (int ai = 0; ai < 2; ++ai)
#pragma unroll
            for (int m = 0; m < 4; ++m) {
                const int row = row0 + ai * 128 + m * 16;
                if constexpr (MODE == 1) {
#pragma unroll
                    for (int bj = 0; bj < 2; ++bj) {
                        const int col = colt + bj * 128;
                        float v[8];
#pragma unroll
                        for (int i = 0; i < 4; ++i) { v[i] = acc[ai][bj][m][0][i]; v[4 + i] = acc[ai][bj][m][1][i]; }
                        bf16* dst;
                        const int bb = row >> 12, tt_ = row & (SEQ - 1);
                        if (kind <= 1) {
                            if (kind == 0) {
#pragma unroll
                                for (int i = 0; i < 8; ++i) v[i] *= QSCALE;
                            }
                            const int which = col >> 9, cw = col & 511;
                            dst = a.att + (size_t)which * ((size_t)M * 512) + ((size_t)(bb * 8 + (cw >> 6)) * SEQ + tt_) * 64 + (cw & 63);
                        } else if (kind == 2 || kind == 3) {
                            if (kind == 3) {
#pragma unroll
                                for (int i = 0; i < 8; ++i) v[i] = v[i] * sigmoidf_(v[i]);
                            }
                            const int cw = (col - 2560) & 511;
                            dst = a.hg + (size_t)kind * ((size_t)M * 512) + ((size_t)(bb * 4 + (cw >> 7)) * SEQ + tt_) * 128 + (cw & 127);
                        } else {
#pragma unroll
                            for (int i = 0; i < 8; ++i) v[i] = sigmoidf_(v[i]);
                            dst = a.g + (size_t)row * GW + (col - 3584);
                        }
                        ST16(dst, pack8(v));
                    }
                } else if constexpr (MODE == 2) {
#pragma unroll
                    for (int bj = 0; bj < 2; ++bj) {
                        const int col = colt + bj * 128;
                        float gb[8], v[8];
                        unpack8(*(const v4u*)(a.gate + (size_t)row * GW + 1024 + col), gb);
#pragma unroll
                        for (int i = 0; i < 4; ++i) { v[i] = fmaxf(gb[i], 1e-30f) * acc[ai][bj][m][0][i]; v[4 + i] = fmaxf(gb[4 + i], 1e-30f) * acc[ai][bj][m][1][i]; }
                        *(v4u*)(a.ob + (size_t)row * D + col) = pack8(v);
                    }
                } else if constexpr (MODE == 4 || MODE == 6 || MODE == 8) {
                    float r = 0.f;
                    if constexpr (MODE == 8) r = __builtin_amdgcn_rsqf(a.rs[row] * (1.0f / D) + EPS);
                    float s = 0.f;
#pragma unroll
                    for (int bj = 0; bj < 2; ++bj) {
                        const int col = colt + bj * 128;
                        const size_t off = (size_t)row * D + col;
                        float xr[8];
                        if constexpr (MODE == 4) { const f32x4 x0 = *(const f32x4*)(a.xres + off), x1 = *(const f32x4*)(a.xres + off + 4);
#pragma unroll
                            for (int i = 0; i < 4; ++i) { xr[i] = x0[i]; xr[4 + i] = x1[i]; } }
                        else unpack8(*(const v4u*)(a.xrb + off), xr);
                        float v[8];
#pragma unroll
                        for (int i = 0; i < 4; ++i) { v[i] = acc[ai][bj][m][0][i]; v[4 + i] = acc[ai][bj][m][1][i]; }
                        if constexpr (MODE == 8) {
                            float e[8]; unpack8(*(const v4u*)(a.gate + off), e);
#pragma unroll
                            for (int i = 0; i < 8; ++i) v[i] = e[i] * sigmoidf_(v[i] * r);
                        }
#pragma unroll
                        for (int i = 0; i < 8; ++i) { v[i] += xr[i]; s += v[i] * v[i]; }
                        *(v4u*)(a.ob + off) = pack8(v);
                    }
                    s += __shfl_xor(s, 16); s += __shfl_xor(s, 32);
                    if (fq == 0) atomicAdd(a.ss + row, s);
                } else if constexpr (MODE == 5) {
                    const float r = __builtin_amdgcn_rsqf(a.rs[row] * (1.0f / D) + EPS);
                    const int hcol = u.pn * 128 + wc * 32 + 8 * fq;
                    float v[8];
#pragma unroll
                    for (int i = 0; i < 4; ++i) {
                        const float g0 = acc[ai][0][m][0][i] * r, u0 = acc[ai][1][m][0][i] * r, g1 = acc[ai][0][m][1][i] * r, u1 = acc[ai][1][m][1][i] * r;
                        v[i] = g0 * sigmoidf_(g0) * u0; v[4 + i] = g1 * sigmoidf_(g1) * u1;
                    }
                    ST16(a.ob + (size_t)row * FF + hcol, pack8(v));
                } else {
#pragma unroll
                    for (int bj = 0; bj < 2; ++bj) {
                        const int col = colt + bj * 128;
                        float v[8];
#pragma unroll
                        for (int i = 0; i < 4; ++i) { v[i] = acc[ai][bj][m][0][i]; v[4 + i] = acc[ai][bj][m][1][i]; }
                        *(v4u*)(a.ob + (size_t)row * D + col) = pack8(v);
                    }
                }
            }
    }
};

DI float wave_sum(float v) {
#pragma unroll
    for (int o = 1; o < 64; o <<= 1) v += __shfl_xor(v, o);
    return v;
}
DI void p0_transpose_item(const float* W, int K, int N, const float* gain, bf16* WT, int GU, LAS float* scr, int item, int lane, int pitch = 0, int coff = 0) {
    if (pitch == 0) pitch = K;
    const int nblk = N / 32, kb = item / nblk, nb = item % nblk, k0 = 64 * kb, n0 = 32 * nb;
    int s0 = n0;
    if (GU == 1) { const int tile = n0 >> 8, j = n0 & 255; s0 = (j < 128) ? tile * 128 + j : FF + tile * 128 + (j - 128); }
    if (GU == 2) { const int tile = n0 >> 8, j = n0 & 255; if (tile >= 6 && tile < 10) s0 = (j < 128) ? 1536 + (tile - 6) * 128 + j : 2048 + (tile - 6) * 128 + (j - 128); }
    float wv[32];
#pragma unroll
    for (int i = 0; i < 32; ++i) wv[i] = W[(size_t)(k0 + 2 * i + (lane >> 5)) * N + s0 + (lane & 31)];
    if (gain) {
#pragma unroll
        for (int i = 0; i < 32; ++i) wv[i] *= gain[k0 + 2 * i + (lane >> 5)];
    }
#pragma unroll
    for (int i = 0; i < 32; ++i) scr[(2 * i + (lane >> 5)) * 33 + (lane & 31)] = wv[i];
    LDS_WAIT(); asm volatile("" ::: "memory");
    const int c = lane & 7;
#pragma unroll
    for (int j = 0; j < 4; ++j) { const int n = (lane >> 3) + 8 * j; const LAS float* s = scr + (8 * c) * 33 + n;
        v4u o; o.x = pg8::cvt_pk_bf16(s[0 * 33], s[1 * 33]); o.y = pg8::cvt_pk_bf16(s[2 * 33], s[3 * 33]); o.z = pg8::cvt_pk_bf16(s[4 * 33], s[5 * 33]); o.w = pg8::cvt_pk_bf16(s[6 * 33], s[7 * 33]);
        *(GAS v4u*)(WT + (size_t)(n0 + n) * pitch + coff + k0 + 8 * c) = o; }
    LDS_WAIT(); asm volatile("" ::: "memory");
}

struct Args { const float* in[16]; float* out; unsigned char* ws; };

typedef short s16x4 __attribute__((ext_vector_type(4)));
typedef float f32x16 __attribute__((ext_vector_type(16)));
typedef float f32x2_t __attribute__((ext_vector_type(2))); typedef __bf16 bf16x2_t __attribute__((ext_vector_type(2)));
typedef short v4i16_t __attribute__((ext_vector_type(4)));
DI unsigned cvtpk_s(float lo, float hi) { f32x2_t v = {lo, hi}; bf16x2_t b = __builtin_convertvector(v, bf16x2_t); return __builtin_bit_cast(unsigned, b); }
DI s16x4 vtr(const LAS unsigned char* p) { return __builtin_bit_cast(s16x4, __builtin_amdgcn_ds_read_tr16_b64_v4i16((LAS v4i16_t*)p)); }
DI int crow(int i, int hh) { return (i & 3) + 8 * (i >> 2) + 4 * hh; }
DI s16x4 vtr_asm(unsigned addr) { s16x4 r; asm volatile("ds_read_b64_tr_b16 %0, %1" : "=v"(r) : "v"(addr) : "memory"); return r; }
#define TR_WAIT4(a, b, c, d) do { asm volatile("s_waitcnt lgkmcnt(0)" : "+v"(a), "+v"(b), "+v"(c), "+v"(d) :: "memory"); __builtin_amdgcn_sched_barrier(0); } while (0)
DI pg8::bf16x8 pack_step(const f32x16& x, int s) {
    v4u p; p.x = cvtpk_s(x[8 * s], x[8 * s + 1]); p.y = cvtpk_s(x[8 * s + 2], x[8 * s + 3]); p.z = cvtpk_s(x[8 * s + 4], x[8 * s + 5]); p.w = cvtpk_s(x[8 * s + 6], x[8 * s + 7]);
    return __builtin_bit_cast(pg8::bf16x8, p);
}
#define MFMA32(a, b, c) __builtin_amdgcn_mfma_f32_32x32x16_bf16((a), (b), (c), 0, 0, 0)
#define HBAR() do { asm volatile("s_waitcnt lgkmcnt(0)" ::: "memory"); __builtin_amdgcn_s_barrier(); asm volatile("" ::: "memory"); } while (0)

#define MFMA16(a, b, c) __builtin_amdgcn_mfma_f32_16x16x32_bf16((a), (b), (c), 0, 0, 0)
struct A16Blk { int d, blk_start, res; };
DI A16Blk a16_blk(int s, int sp) {
    const int pass = s >> 4, bi = s & 15, d = (pass == 0) ? 16 : (pass == 1) ? 4 : 1, bpr = 16 / d;
    A16Blk B; B.d = d; B.res = bi / bpr; B.blk_start = sp * (2048 / d) + (bi % bpr) * 128; return B;
}
DI void a16_dma(LAS unsigned char* kbuf, LAS unsigned char* vbuf, LAS unsigned char* qbuf, const bf16* Qh, const bf16* Kh, const bf16* Vh, const A16Blk& B, int wave, int lane) {
#pragma unroll
    for (int i = 0; i < 4; ++i) {
        const int pc = wave * 4 + i, kk = pc * 8 + (lane >> 3);
        int l = B.blk_start - 128 + kk; if (l < 0) l = 0;
        const size_t rowi = (size_t)(l * B.d + B.res) * 64;
        const int ck = (lane & 7) ^ ((kk >> 1) & 7);
        const int cv = ((((lane & 7) >> 1) ^ ((kk >> 1) & 3)) << 1) + (lane & 1);
        __builtin_amdgcn_global_load_lds((const unsigned*)(Kh + rowi + ck * 8), (LAS unsigned*)(kbuf + pc * 1024), 16, 0, 0);
        __builtin_amdgcn_global_load_lds((const unsigned*)(Vh + rowi + cv * 8), (LAS unsigned*)(vbuf + pc * 1024), 16, 0, 0);
    }
#pragma unroll
    for (int i = 0; i < 2; ++i) {
        const int qr = i * 8 + (lane >> 3);
        const size_t rowq = (size_t)((B.blk_start + 16 * wave + qr) * B.d + B.res) * 64;
        __builtin_amdgcn_global_load_lds((const unsigned*)(Qh + rowq + (((lane & 7) ^ ((qr >> 1) & 7)) << 3)), (LAS unsigned*)(qbuf + i * 1024), 16, 0, 0);
    }
}
DI void attn16_unit(LAS unsigned char* lds, const bf16* ATT, bf16* Y, float* LSE, int b, int h, int sp, int tid) {
    const int lane = tid & 63, wave = __builtin_amdgcn_readfirstlane(tid >> 6);
    const int c = lane & 15, g = lane >> 4, tq4 = c >> 2, tp = c & 3;
    const bf16* Qh = ATT + (size_t)(b * 8 + h) * SEQ * 64; const bf16* Kh = Qh + (size_t)M * 512; const bf16* Vh = Kh + (size_t)M * 512;
    constexpr int NS = 48;
    { const A16Blk B0 = a16_blk(0, sp); a16_dma(lds, lds + 32768, lds + RING_BYTES + wave * 2048, Qh, Kh, Vh, B0, wave, lane); }
    VM_WAIT();
#pragma unroll 2
    for (int s = 0; s < NS; ++s) {
        const A16Blk B = a16_blk(s, sp);
        const int bs = s & 1, pass = s >> 4;
        LAS unsigned char* kb = lds + bs * 65536; LAS unsigned char* vb = kb + 32768;
        LAS unsigned char* qs = lds + RING_BYTES + bs * 16384 + wave * 2048;
        if (s == 16 || s == 32) {
            VM_WAIT(); HBAR();
            __builtin_amdgcn_fence(__ATOMIC_ACQUIRE, "agent");
            VM_WAIT();
        }
        asm volatile("s_waitcnt vmcnt(3)" ::: "memory"); HBAR();
        const size_t rowb = (size_t)b * SEQ + B.res;
        const int q0 = B.blk_start + 16 * wave;
        bf16* ybase = Y + rowb * 1024 + h * 64 + (lane & 7) * 8;
        const size_t tokc = rowb + (size_t)((q0 + c) * B.d);
        v4u prw0, prw1; float lp;
        if (pass > 0) {
            asm volatile("global_load_dwordx4 %0, %1, off" : "=v"(prw0) : "v"(ybase + (size_t)((q0 + (lane >> 3)) * B.d) * 1024) : "memory");
            asm volatile("global_load_dwordx4 %0, %1, off" : "=v"(prw1) : "v"(ybase + (size_t)((q0 + (lane >> 3) + 8) * B.d) * 1024) : "memory");
            asm volatile("global_load_dword %0, %1, off" : "=v"(lp) : "v"(LSE + tokc * 8 + h) : "memory");
        } else asm volatile("" : "=v"(prw0), "=v"(prw1), "=v"(lp));
        { const A16Blk Bn = a16_blk(s + 1 < NS ? s + 1 : s, sp);
            a16_dma(lds + (bs ^ 1) * 65536, lds + (bs ^ 1) * 65536 + 32768, lds + RING_BYTES + (bs ^ 1) * 16384 + wave * 2048, Qh, Kh, Vh, Bn, wave, lane); }
        pg8::bf16x8 qf[2];
#pragma unroll
        for (int sx = 0; sx < 2; ++sx) qf[sx] = *(const LAS pg8::bf16x8*)(qs + c * 128 + (((4 * sx + g) ^ ((c >> 1) & 7)) << 4));
        f32x4 S[10];
#pragma unroll
        for (int kt = 0; kt < 9; ++kt) {
            S[kt] = (f32x4){0.f, 0.f, 0.f, 0.f};
            const int key = 16 * wave + 16 * kt + c;
#pragma unroll
            for (int sx = 0; sx < 2; ++sx) {
                const pg8::bf16x8 kf = *(const LAS pg8::bf16x8*)(kb + key * 128 + (((4 * sx + g) ^ ((key >> 1) & 7)) << 4));
                S[kt] = MFMA16(kf, qf[sx], S[kt]);
            }
        }
        S[9] = (f32x4){0.f, 0.f, 0.f, 0.f};
        const float NEG = -1e30f;
#pragma unroll
        for (int i = 0; i < 4; ++i) { const int kr = 4 * g + i; S[0][i] = (kr >= c) ? S[0][i] : NEG; S[8][i] = (kr <= c) ? S[8][i] : NEG; }
        if (B.blk_start == 0) {
#pragma unroll
            for (int kt = 0; kt < 8; ++kt) if (wave + kt < 8) S[kt] = (f32x4){NEG, NEG, NEG, NEG};
        }
        float mx = NEG;
#pragma unroll
        for (int kt = 0; kt < 9; ++kt)
#pragma unroll
            for (int i = 0; i < 4; ++i) mx = fmaxf(mx, S[kt][i]);
        mx = fmaxf(mx, __shfl_xor(mx, 16)); mx = fmaxf(mx, __shfl_xor(mx, 32));
        float l = 0.f;
#pragma unroll
        for (int kt = 0; kt < 9; ++kt)
#pragma unroll
            for (int i = 0; i < 4; ++i) { const float pv = __builtin_amdgcn_exp2f(S[kt][i] - mx); S[kt][i] = pv; l += pv; }
        l += __shfl_xor(l, 16); l += __shfl_xor(l, 32);
        f32x4 O[4];
#pragma unroll
        for (int t = 0; t < 4; ++t) O[t] = (f32x4){0.f, 0.f, 0.f, 0.f};
#pragma unroll
        for (int j = 0; j < 5; ++j) {
            v4u pw; pw.x = cvtpk_s(S[2 * j][0], S[2 * j][1]); pw.y = cvtpk_s(S[2 * j][2], S[2 * j][3]); pw.z = cvtpk_s(S[2 * j + 1][0], S[2 * j + 1][1]); pw.w = cvtpk_s(S[2 * j + 1][2], S[2 * j + 1][3]);
            const pg8::bf16x8 pb = __builtin_bit_cast(pg8::bf16x8, pw);
            const int klo = 16 * wave + 32 * j + 4 * g + tq4, khi = (j < 4) ? klo + 16 : klo;
            const unsigned vb32 = (unsigned)(size_t)vb;
#define V16A(k_, t_) (vb32 + (k_) * 128 + (((t_) ^ (((k_) >> 1) & 3)) << 5) + 8 * tp)
            s16x4 l0 = vtr_asm(V16A(klo, 0)), h0 = vtr_asm(V16A(khi, 0)), l1 = vtr_asm(V16A(klo, 1)), h1 = vtr_asm(V16A(khi, 1));
            s16x4 l2 = vtr_asm(V16A(klo, 2)), h2 = vtr_asm(V16A(khi, 2)), l3 = vtr_asm(V16A(klo, 3)), h3 = vtr_asm(V16A(khi, 3));
#undef V16A
            asm volatile("s_waitcnt lgkmcnt(0)" : "+v"(l0), "+v"(h0), "+v"(l1), "+v"(h1), "+v"(l2), "+v"(h2), "+v"(l3), "+v"(h3) :: "memory"); __builtin_amdgcn_sched_barrier(0);
            O[0] = MFMA16(__builtin_shufflevector(l0, h0, 0, 1, 2, 3, 4, 5, 6, 7), pb, O[0]);
            O[1] = MFMA16(__builtin_shufflevector(l1, h1, 0, 1, 2, 3, 4, 5, 6, 7), pb, O[1]);
            O[2] = MFMA16(__builtin_shufflevector(l2, h2, 0, 1, 2, 3, 4, 5, 6, 7), pb, O[2]);
            O[3] = MFMA16(__builtin_shufflevector(l3, h3, 0, 1, 2, 3, 4, 5, 6, 7), pb, O[3]);
        }
        asm volatile("s_waitcnt vmcnt(10)" : "+v"(prw0), "+v"(prw1), "+v"(lp) :: "memory");
        float lse = mx + __builtin_amdgcn_logf(l);
        const float invl = 1.0f / l;
        const bool mrg = pass > 0;
        const float lpp = mrg ? lp : lse;
        const float mm = fmaxf(lpp, lse), ep = __builtin_amdgcn_exp2f(lpp - mm), en = __builtin_amdgcn_exp2f(lse - mm), inv = 1.0f / (ep + en);
        const float wp = ep * inv, wn = mrg ? en * inv * invl : invl;
        lse = mrg ? mm + __builtin_amdgcn_logf(ep + en) : lse;
        LDS_WAIT();
        { const int qr = (lane >> 3); *(LAS v4u*)(qs + qr * 128 + (((lane & 7) ^ (qr & 7)) << 4)) = prw0; *(LAS v4u*)(qs + (qr + 8) * 128 + (((lane & 7) ^ (qr & 7)) << 4)) = prw1; }
        LDS_WAIT();
#pragma unroll
        for (int t = 0; t < 4; ++t) {
            LAS unsigned char* ap = qs + c * 128 + (((2 * t + (g >> 1)) ^ (c & 7)) << 4) + 8 * (g & 1);
            const v2u pq = *(const LAS v2u*)ap;
            float o0 = O[t][0] * wn, o1 = O[t][1] * wn, o2 = O[t][2] * wn, o3 = O[t][3] * wn;
            const float m0 = o0 + wp * bflo(pq.x), m1 = o1 + wp * bfhi(pq.x), m2 = o2 + wp * bflo(pq.y), m3 = o3 + wp * bfhi(pq.y);
            o0 = mrg ? m0 : o0; o1 = mrg ? m1 : o1; o2 = mrg ? m2 : o2; o3 = mrg ? m3 : o3;
            v2u w; w.x = cvtpk_s(o0, o1); w.y = cvtpk_s(o2, o3);
            *(LAS v2u*)ap = w;
        }
        LDS_WAIT();
        v4u ow[2];
#pragma unroll
        for (int j = 0; j < 2; ++j) { const int qr = (lane >> 3) + 8 * j; ow[j] = *(const LAS v4u*)(qs + qr * 128 + (((lane & 7) ^ (qr & 7)) << 4)); }
#pragma unroll
        for (int j = 0; j < 2; ++j) *(v4u*)(ybase + (size_t)((q0 + (lane >> 3) + 8 * j) * B.d) * 1024) = ow[j];
        if (g == 0) LSE[tokc * 8 + h] = lse;
    }
    VM_WAIT(); HBAR();
}

constexpr int H_STAGE = 49152, H_QT = 0, H_KH = 16384, H_VV = 32768, H_ST = 98304, H_PSS = RING_BYTES + 1024;
DI int fsw(int s) { return ((s & 3) << 2) | ((s >> 2) & 3); }
DI pg8::bf16x8 rowfrag(const LAS unsigned char* base, int row, int ks, int hh) { return *(const LAS pg8::bf16x8*)(base + row * 256 + (((2 * ks + hh) ^ fsw(row)) << 4)); }

template <int NIMG> DI void hgrn_dma(LAS unsigned char* stg, const bf16* HG, size_t row0, int h, int wave, int lane) {
    const int t4 = lane >> 4, pc = lane & 15;
#pragma unroll
    for (int i = 0; i < 2 * NIMG; ++i) {
        const int p = wave * 2 * NIMG + i;
        const int img = p >> 4, pp = p & 15, t = pp * 4 + t4;
        const int im = (NIMG == 3) ? img : img + 1;
        int c;
        if (im < 2) c = pc ^ fsw(t); else c = (((pc >> 2) ^ (t & 3)) << 2) + (pc & 3);
        const bf16* src = HG + (size_t)im * ((size_t)M * 512) + ((size_t)((row0 >> 12) * 4 + h) * SEQ + (row0 & (SEQ - 1)) + t) * 128 + c * 8;
        __builtin_amdgcn_global_load_lds((const unsigned*)src, (LAS unsigned*)(stg + im * 16384 + pp * 1024), 16, 0, 0);
    }
}

DI void hgrn_vfrags(const LAS unsigned char* stg, pg8::bf16x8 (&vf)[2][2], int vt, int hh, int tq, int tp, int tblk) {
    const unsigned vb32 = (unsigned)(size_t)stg + H_VV;
    const int k0 = 4 * hh + tq;
#define HVA(k_) (vb32 + (k_) * 256 + ((vt ^ ((k_) & 3)) << 6) + 32 * tblk + 8 * tp)
    s16x4 a0 = vtr_asm(HVA(k0)), a1 = vtr_asm(HVA(k0 + 8)), a2 = vtr_asm(HVA(k0 + 16)), a3 = vtr_asm(HVA(k0 + 24));
    s16x4 a4 = vtr_asm(HVA(k0 + 32)), a5 = vtr_asm(HVA(k0 + 40)), a6 = vtr_asm(HVA(k0 + 48)), a7 = vtr_asm(HVA(k0 + 56));
#undef HVA
    asm volatile("s_waitcnt lgkmcnt(0)" : "+v"(a0), "+v"(a1), "+v"(a2), "+v"(a3), "+v"(a4), "+v"(a5), "+v"(a6), "+v"(a7) :: "memory"); __builtin_amdgcn_sched_barrier(0);
    vf[0][0] = __builtin_shufflevector(a0, a1, 0, 1, 2, 3, 4, 5, 6, 7); vf[0][1] = __builtin_shufflevector(a2, a3, 0, 1, 2, 3, 4, 5, 6, 7);
    vf[1][0] = __builtin_shufflevector(a4, a5, 0, 1, 2, 3, 4, 5, 6, 7); vf[1][1] = __builtin_shufflevector(a6, a7, 0, 1, 2, 3, 4, 5, 6, 7);
}
DI void hgrn_update(const LAS unsigned char* stg, f32x16 (&Sacc)[2], const pg8::bf16x8 (&vf)[2][2], int tt, int hh, int tq, int tp, int tblk) {
    const unsigned kb32 = (unsigned)(size_t)stg + H_KH;
    const int k0 = 4 * hh + tq;
#pragma unroll
    for (int j = 0; j < 2; ++j) {
        const int kt = 2 * tt + j, cch = 4 * kt + 2 * tblk + (tp >> 1);
#define HKA(k_) (kb32 + (k_) * 256 + ((cch ^ fsw(k_)) << 4) + 8 * (tp & 1))
#pragma unroll
        for (int st = 0; st < 2; ++st) {
            s16x4 a0 = vtr_asm(HKA(k0 + 32 * st)), a1 = vtr_asm(HKA(k0 + 32 * st + 8)), a2 = vtr_asm(HKA(k0 + 32 * st + 16)), a3 = vtr_asm(HKA(k0 + 32 * st + 24));
            TR_WAIT4(a0, a1, a2, a3);
            Sacc[j] = MFMA32(vf[st][0], __builtin_shufflevector(a0, a1, 0, 1, 2, 3, 4, 5, 6, 7), Sacc[j]);
            Sacc[j] = MFMA32(vf[st][1], __builtin_shufflevector(a2, a3, 0, 1, 2, 3, 4, 5, 6, 7), Sacc[j]);
        }
#undef HKA
    }
}

DI void hgrn_dmaA(LAS unsigned char* lds, int st, const bf16* HG, const float* DCH, size_t row0, int h, int wave, int lane) {
    hgrn_dma<2>(lds + st * 32768, HG, row0, h, wave, lane);
    if (wave < 2) __builtin_amdgcn_global_load_lds((const unsigned*)(DCH + ((row0 >> 6) * 4 + h) * 128 + wave * 64 + lane), (LAS unsigned*)(lds + 114688 + st * 512 + wave * 256), 4, 0, 0);
}
DI void hgrn_passA(LAS unsigned char* lds, const bf16* HG, const float* DCH, float* EST, float* DSEG, int bx, int G, int tid) {
    const int lane = tid & 63, wave = __builtin_amdgcn_readfirstlane(tid >> 6), vt = wave >> 1, tt = wave & 1;
    const int r = lane & 31, hh = lane >> 5, i16 = lane & 15, tq = i16 >> 2, tp = i16 & 3, tblk = (lane >> 4) & 1;
    const int nu = (bx < 1024) ? (1024 - bx + G - 1) / G : 0, nci = nu * 4;
    if (nci == 0) return;
    f32x16 Sacc[2]; float dprod[2] = {1.f, 1.f};
#define PA_ROW(ci_) ((size_t)(((bx + ((ci_) >> 2) * G) & 63) >> 2) * SEQ + ((bx + ((ci_) >> 2) * G) >> 6) * 256 + ((ci_) & 3) * 64)
#define PA_H(ci_) (((bx + ((ci_) >> 2) * G) & 63) & 3)
    hgrn_dmaA(lds, 0, HG, DCH, PA_ROW(0), PA_H(0), wave, lane);
    if (nci > 1) hgrn_dmaA(lds, 1, HG, DCH, PA_ROW(1), PA_H(1), wave, lane);
    if (nci > 1) { if (wave < 2) asm volatile("s_waitcnt vmcnt(5)" ::: "memory"); else asm volatile("s_waitcnt vmcnt(4)" ::: "memory"); } else VM_WAIT();
    HBAR();
    int st = 0;
    for (int ci = 0; ci < nci; ++ci) {
        const int u = bx + (ci >> 2) * G, c = ci & 3, bh = u & 63, seg = u >> 6, sid = bh * 16 + seg;
        LAS unsigned char* stg = lds + st * 32768;
        const LAS float* DV = (const LAS float*)(lds + 114688 + st * 512);
        const int st2 = (st == 0) ? 2 : st - 1;
        if (ci + 2 < nci) hgrn_dmaA(lds, st2, HG, DCH, PA_ROW(ci + 2), PA_H(ci + 2), wave, lane);
        if (c == 0) {
#pragma unroll
            for (int j = 0; j < 2; ++j) { dprod[j] = 1.f;
#pragma unroll
                for (int i = 0; i < 16; ++i) Sacc[j][i] = 0.f; }
        }
#pragma unroll
        for (int j = 0; j < 2; ++j) { const float dk = DV[32 * (2 * tt + j) + r]; dprod[j] *= dk;
#pragma unroll
            for (int i = 0; i < 16; ++i) Sacc[j][i] *= dk; }
        pg8::bf16x8 vf[2][2];
        hgrn_vfrags(stg, vf, vt, hh, tq, tp, tblk);
        hgrn_update(stg, Sacc, vf, tt, hh, tq, tp, tblk);
        if (c == 3) {
#pragma unroll
            for (int j = 0; j < 2; ++j)
#pragma unroll
                for (int i = 0; i < 16; ++i) EST[(size_t)sid * 16384 + (32 * vt + crow(i, hh)) * 128 + 32 * (2 * tt + j) + r] = Sacc[j][i];
            if (vt == 0 && hh == 0) { DSEG[sid * 128 + 64 * tt + r] = dprod[0]; DSEG[sid * 128 + 64 * tt + 32 + r] = dprod[1]; }
        }
        if (ci + 2 < nci) { if (wave < 2) asm volatile("s_waitcnt vmcnt(5)" ::: "memory"); else asm volatile("s_waitcnt vmcnt(4)" ::: "memory"); } else VM_WAIT();
        HBAR();
        st = (st == 2) ? 0 : st + 1;
    }
#undef PA_ROW
#undef PA_H
}
DI void hgrn_passB(float* EST, const float* DSEG, int bx, int G, int tid) {
    for (int w = bx; w < 256; w += G) {
        const int bh = w >> 2, e0 = (w & 3) * 4096 + tid * 8, k0 = e0 & 127;
        f32x4 s0 = {0.f, 0.f, 0.f, 0.f}, s1 = {0.f, 0.f, 0.f, 0.f};
#pragma unroll 5
        for (int seg = 1; seg < 16; ++seg) {
            const int sp = bh * 16 + seg - 1;
            const f32x4 d0 = *(const f32x4*)(DSEG + sp * 128 + k0), d1 = *(const f32x4*)(DSEG + sp * 128 + k0 + 4);
            const f32x4 x0 = *(const f32x4*)(EST + (size_t)sp * 16384 + e0), x1 = *(const f32x4*)(EST + (size_t)sp * 16384 + e0 + 4);
            s0 = d0 * s0 + x0; s1 = d1 * s1 + x1;
            *(f32x4*)(EST + (size_t)sp * 16384 + e0) = s0; *(f32x4*)(EST + (size_t)sp * 16384 + e0 + 4) = s1;
        }
    }
}
DI void hgrn_passC(LAS unsigned char* lds, const bf16* HG, const float* DCH, const float* hg_norm, const float* SST, bf16* YB, int bx, int G, int tid) {
    const int lane = tid & 63, wave = __builtin_amdgcn_readfirstlane(tid >> 6), vt = wave >> 1, tt = wave & 1;
    const int r = lane & 31, hh = lane >> 5, i16 = lane & 15, tq = i16 >> 2, tp = i16 & 3, tblk = (lane >> 4) & 1;
    const int nu = (bx < 1024) ? (1024 - bx + G - 1) / G : 0, nci = nu * 4;
    if (nci == 0) return;
    f32x16 Sacc[2]; float dnext[2];
    if (tid < 128) ((LAS float*)(lds + H_PSS + 1024))[tid] = hg_norm[tid];
    { const int u = bx, bh = u & 63, seg = u >> 6; const size_t row0 = (size_t)(bh >> 2) * SEQ + seg * 256;
        hgrn_dma<3>(lds, HG, row0, bh & 3, wave, lane);
        const float* dp = DCH + ((row0 >> 6) * 4 + (bh & 3)) * 128;
        dnext[0] = dp[64 * tt + r]; dnext[1] = dp[64 * tt + 32 + r]; }
    VM_WAIT(); HBAR();
    for (int ci = 0; ci < nci; ++ci) {
        const int u = bx + (ci >> 2) * G, c = ci & 3, bh = u & 63, seg = u >> 6, h = bh & 3, sid = bh * 16 + seg;
        const size_t row0 = (size_t)(bh >> 2) * SEQ + seg * 256 + c * 64;
        LAS unsigned char* stg = lds + (ci & 1) * H_STAGE;
        const float dcur[2] = {dnext[0], dnext[1]};
        if (c == 0) {
#pragma unroll
            for (int j = 0; j < 2; ++j)
#pragma unroll
                for (int i = 0; i < 16; ++i) Sacc[j][i] = (seg > 0) ? SST[(size_t)(sid - 1) * 16384 + (32 * vt + crow(i, hh)) * 128 + 32 * (2 * tt + j) + r] : 0.f;
        }
        if (ci + 1 < nci) {
            const int u2 = bx + ((ci + 1) >> 2) * G, bh2 = u2 & 63; const size_t row2 = (size_t)(bh2 >> 2) * SEQ + (u2 >> 6) * 256 + ((ci + 1) & 3) * 64;
            const float* dp = DCH + ((row2 >> 6) * 4 + (bh2 & 3)) * 128;
            dnext[0] = dp[64 * tt + r]; dnext[1] = dp[64 * tt + 32 + r];
            hgrn_dma<3>(lds + ((ci + 1) & 1) * H_STAGE, HG, row2, bh2 & 3, wave, lane);
        }
        const int nt_ = tid >> 3, nv0 = (tid & 7) * 16;
        const size_t nrow = row0 + nt_;
        const bf16* gp = HG + (size_t)3 * ((size_t)M * 512) + ((size_t)((nrow >> 12) * 4 + h) * SEQ + (nrow & (SEQ - 1))) * 128 + nv0;
        const v4u gq0 = *(const v4u*)gp, gq1 = *(const v4u*)(gp + 8);
#pragma unroll
        for (int j = 0; j < 2; ++j) { const int kk = 32 * (2 * tt + j) + r;
#pragma unroll
            for (int i = 0; i < 16; ++i) { Sacc[j][i] *= dcur[j]; const int v = 32 * vt + crow(i, hh);
                *(LAS bf16*)(lds + H_ST + v * 256 + (((kk >> 3) ^ fsw(v)) << 4) + (kk & 7) * 2) = (bf16)cvtpk_s(Sacc[j][i], 0.f); } }
        HBAR();
        pg8::bf16x8 qb[8];
#pragma unroll
        for (int ks = 0; ks < 8; ++ks) qb[ks] = rowfrag(stg + H_QT, 32 * tt + r, ks, hh);
        pg8::bf16x8 vf[2][2];
        hgrn_vfrags(stg, vf, vt, hh, tq, tp, tblk);
        f32x16 O;
#pragma unroll
        for (int i = 0; i < 16; ++i) O[i] = 0.f;
#pragma unroll
        for (int ks = 0; ks < 8; ++ks) O = MFMA32(rowfrag(lds + H_ST, 32 * vt + r, ks, hh), qb[ks], O);
#pragma unroll
        for (int st = 0; st < 2; ++st) {
            if (st <= tt) {
                f32x16 X;
#pragma unroll
                for (int i = 0; i < 16; ++i) X[i] = 0.f;
#pragma unroll
                for (int ks = 0; ks < 8; ++ks) X = MFMA32(rowfrag(stg + H_KH, 32 * st + r, ks, hh), qb[ks], X);
                if (st == tt) {
#pragma unroll
                    for (int i = 0; i < 16; ++i) X[i] = (crow(i, hh) <= r) ? X[i] : 0.f;
                }
#pragma unroll
                for (int s_ = 0; s_ < 2; ++s_) O = MFMA32(vf[st][s_], pack_step(X, s_), O);
            }
        }
        if (c < 3) hgrn_update(stg, Sacc, vf, tt, hh, tq, tp, tblk);
        HBAR();
        { float ss = 0.f;
#pragma unroll
            for (int i = 0; i < 16; ++i) ss += O[i] * O[i];
            ss += __shfl_xor(ss, 32);
            const int t = 32 * tt + r;
#pragma unroll
            for (int g4 = 0; g4 < 4; ++g4) { const int c16 = (32 * vt + 8 * g4 + 4 * hh) >> 2;
                *(LAS f32x4*)(lds + H_ST + t * 512 + ((c16 ^ (t & 31)) << 4)) = (f32x4){O[4 * g4], O[4 * g4 + 1], O[4 * g4 + 2], O[4 * g4 + 3]}; }
            if (hh == 0) ((LAS float*)(lds + H_PSS))[vt * 64 + t] = ss; }
        HBAR();
        { const int t = nt_, v0 = nv0;
            const LAS float* PSS = (const LAS float*)(lds + H_PSS);
            const float ss = (PSS[t] + PSS[64 + t]) + (PSS[128 + t] + PSS[192 + t]);
            const float rstd = __builtin_amdgcn_rsqf(ss * (1.0f / 128.0f) + EPS);
            bf16* yp = YB + nrow * 1024 + 512 + h * 128 + v0;
#pragma unroll
            for (int q8 = 0; q8 < 2; ++q8) {
                float gv[8], ov[8]; unpack8(q8 ? gq1 : gq0, gv);
                const int ca = (v0 + 8 * q8) >> 2;
                const f32x4 oa = *(const LAS f32x4*)(lds + H_ST + t * 512 + ((ca ^ (t & 31)) << 4)), ob = *(const LAS f32x4*)(lds + H_ST + t * 512 + (((ca + 1) ^ (t & 31)) << 4));
                const f32x4 na = *(const LAS f32x4*)(lds + H_PSS + 1024 + (v0 + 8 * q8) * 4), nb = *(const LAS f32x4*)(lds + H_PSS + 1024 + (v0 + 8 * q8 + 4) * 4);
#pragma unroll
                for (int i = 0; i < 4; ++i) { ov[i] = oa[i] * rstd * na[i] * gv[i]; ov[4 + i] = ob[i] * rstd * nb[i] * gv[4 + i]; }
                *(v4u*)(yp + 8 * q8) = pack8(ov);
            }
        }
        asm volatile("s_waitcnt vmcnt(2)" ::: "memory"); HBAR();
    }
}

__global__ void __launch_bounds__(NTHR, 2) fwd_kernel(Args args) {
    extern __shared__ __attribute__((aligned(16))) unsigned char lds_raw[];
    LAS unsigned char* lds = (LAS unsigned char*)lds_raw;
    volatile LAS unsigned* MISC = (volatile LAS unsigned*)(lds + MISC_OFF);
    const int tid = threadIdx.x, lane = tid & 63, wave = __builtin_amdgcn_readfirstlane(tid >> 6);
    const int G = gridDim.x, bx = blockIdx.x;
    unsigned char* ws = args.ws;
    gu32* ctl = (gu32*)(ws + WS_CTL);
    const float* x = args.in[0]; const float* p = args.in[1]; const float* norm_mix = args.in[2]; const float* w_in = args.in[3]; const float* hg_lb = args.in[4]; const float* hg_norm = args.in[5];
    const float* w_a_up = args.in[6]; const float* w_b_up = args.in[7]; const float* w_out = args.in[8]; const float* norm_ffn = args.in[9]; const float* w_gu = args.in[10]; const float* w_down = args.in[11];
    const float* norm_ple = args.in[12]; const float* w_pe = args.in[13]; const float* w_pg = args.in[14]; const float* norm_final = args.in[15];
    float* out = args.out;
    bf16* WIN = (bf16*)(ws + WS_WIN); bf16* WGU = (bf16*)(ws + WS_WGU); bf16* WDN = (bf16*)(ws + WS_WDN); bf16* WOUT = (bf16*)(ws + WS_WOUT); bf16* WPG = (bf16*)(ws + WS_WPG);
    bf16* WA = (bf16*)(ws + WS_WA); bf16* WB = (bf16*)(ws + WS_WB); bf16* WPE = (bf16*)(ws + WS_WPE);
    bf16* PB = (bf16*)(ws + WS_PB); bf16* XB = (bf16*)(ws + WS_XB); bf16* YA = (bf16*)(ws + WS_YA); bf16* YB = (bf16*)(ws + WS_YB);
    bf16* ATT = (bf16*)(ws + WS_ATT); bf16* HG = (bf16*)(ws + WS_HG); bf16* GT = (bf16*)(ws + WS_GT);
    float* LSEB = (float*)(ws + WS_LSE);
    float* EST = (float*)(ws + WS_EST); float* DSEG = (float*)(ws + WS_DSEG);
    float* DCH = (float*)(ws + WS_DCH);
    bf16* MRG = ATT; bf16* X1B = HG; bf16* HID = GT; bf16* X2B = ATT; bf16* PE = XB; bf16* X3B = HG;
    float* SS1 = (float*)(ctl + CW_SS1); float* SS2 = (float*)(ctl + CW_SS2); float* SS3 = (float*)(ctl + CW_SS3);

    for (int u = tid; u < (LDS_BYTES - LDSCTL_OFF) / 4; u += NTHR) ((LAS unsigned*)(lds + LDSCTL_OFF))[u] = 0u;
    __syncthreads();
    XcdBarrier bar = xcd_barrier_post((unsigned*)(ctl + CW_BAR), MISC + 8);

    {
        LAS float* scr = (LAS float*)(lds + RING_OFF + wave * 16384);
        const int gw = bx * NWAVES + wave, NGW = G * NWAVES;
        constexpr int I_IN = (D / 64) * (NIN / 32), I_GU = I_IN, I_DN = (FF / 64) * (D / 32), I_SQ = (D / 64) * (D / 32), I_AB = (512 / 64) * (D / 32), I_PE = (PLE / 64) * (D / 32);
        constexpr int NITEMS = I_IN + I_GU + I_DN + 2 * I_SQ + 2 * I_AB + I_PE;
        for (int it = gw; it < NITEMS; it += NGW) {
            int r = it;
            if (r < I_IN) { p0_transpose_item(w_in, D, NIN, norm_mix, WIN, 2, scr, r, lane); continue; } r -= I_IN;
            if (r < I_GU) { p0_transpose_item(w_gu, D, NIN, norm_ffn, WGU, 1, scr, r, lane); continue; } r -= I_GU;
            if (r < I_DN) { p0_transpose_item(w_down, FF, D, nullptr, WDN, 0, scr, r, lane); continue; } r -= I_DN;
            if (r < I_SQ) { p0_transpose_item(w_out, D, D, nullptr, WOUT, 0, scr, r, lane); continue; } r -= I_SQ;
            if (r < I_SQ) { p0_transpose_item(w_pg, D, D, norm_ple, WPG, 0, scr, r, lane); continue; } r -= I_SQ;
            if (r < I_AB) { p0_transpose_item(w_a_up, 512, D, nullptr, WA, 0, scr, r, lane, 1024, 0); continue; } r -= I_AB;
            if (r < I_AB) { p0_transpose_item(w_b_up, 512, D, nullptr, WA, 0, scr, r, lane, 1024, 512); continue; } r -= I_AB;
            p0_transpose_item(w_pe, PLE, D, nullptr, WPE, 0, scr, r, lane);
        }
        for (int m0 = 4 * gw; m0 < M; m0 += 4 * NGW) {
            f32x4 v[4][4], pv[4];
#pragma unroll
            for (int rr = 0; rr < 4; ++rr) {
                const GAS f32x4* xr = (const GAS f32x4*)(x + (size_t)(m0 + rr) * D) + lane;
#pragma unroll
                for (int j = 0; j < 4; ++j) v[rr][j] = xr[64 * j];
                pv[rr] = ((const GAS f32x4*)(p + (size_t)(m0 + rr) * PLE))[lane];
            }
#pragma unroll
            for (int rr = 0; rr < 4; ++rr) {
                float s = 0.f;
#pragma unroll
                for (int j = 0; j < 4; ++j) s += (v[rr][j].x * v[rr][j].x + v[rr][j].y * v[rr][j].y) + (v[rr][j].z * v[rr][j].z + v[rr][j].w * v[rr][j].w);
                s = wave_sum(s);
                const float rs = __builtin_amdgcn_rsqf(s * (1.0f / D) + EPS);
                GAS v2u* o8 = (GAS v2u*)(XB + (size_t)(m0 + rr) * D) + lane;
#pragma unroll
                for (int j = 0; j < 4; ++j) { v2u w; w.x = pg8::cvt_pk_bf16(v[rr][j].x * rs, v[rr][j].y * rs); w.y = pg8::cvt_pk_bf16(v[rr][j].z * rs, v[rr][j].w * rs); o8[64 * j] = w; }
                v2u w; w.x = pg8::cvt_pk_bf16(pv[rr].x, pv[rr].y); w.y = pg8::cvt_pk_bf16(pv[rr].z, pv[rr].w);
                ((GAS v2u*)(PB + (size_t)(m0 + rr) * PLE))[lane] = w;
            }
        }
    }
    xcd_barrier(bar);

    {
        pg8::Gemm g{XB, WIN, M, NIN, D}; pg8::StaticOrder S; S.init(M, NIN, G, bx);
        Epi<1> E{}; E.a.att = ATT; E.a.hg = HG; E.a.g = GT; E.a.hg_lb = hg_lb; E.a.dch = DCH;
        pg8::gemm_phase<Epi<1>, pg8::StaticOrder, true, true>(lds + RING_OFF, g, S, E);
    }
    xcd_barrier(bar);

#define HG_ALL() do { hgrn_passA(lds, HG, DCH, EST, DSEG, bx, G, tid); xcd_barrier(bar); hgrn_passB(EST, DSEG, bx, G, tid); xcd_barrier(bar); \
    hgrn_passC(lds, HG, DCH, hg_norm, EST, YB, bx, G, tid); } while (0)
    HG_ALL();
    for (int u = bx; u < 256; u += G) attn16_unit(lds + RING_OFF, ATT, YA, LSEB, u >> 4, (u >> 1) & 7, u & 1, tid);
    __syncthreads();
    for (int u = tid; u < (LDS_BYTES - LDSCTL_OFF) / 4; u += NTHR) ((LAS unsigned*)(lds + LDSCTL_OFF))[u] = 0u;
    __syncthreads();
    xcd_barrier(bar);

    {
        pg8::SplitOrder S; S.init(M, D, G, bx);
        pg8::Gemm g{YA, WA, M, D, 512, 1024}; Epi<2> E{}; E.a.gate = GT; E.a.ob = MRG;
        pg8::gemm_phase<Epi<2>, pg8::SplitOrder, true, true>(lds + RING_OFF, g, S, E);
    }
    xcd_barrier(bar);

    {
        pg8::Gemm g{MRG, WOUT, M, D, D}; pg8::StaticOrder S; S.init(M, D, G, bx);
        Epi<4> E{}; E.a.xres = x; E.a.ob = X1B; E.a.ss = SS1;
        pg8::gemm_phase<Epi<4>, pg8::StaticOrder, true, true>(lds + RING_OFF, g, S, E);
    }
    xcd_barrier(bar);

    {
        pg8::Gemm g{X1B, WGU, M, NIN, D}; pg8::StaticOrder S; S.init(M, NIN, G, bx);
        Epi<5> E{}; E.a.rs = SS1; E.a.ob = HID;
        pg8::gemm_phase<Epi<5>, pg8::StaticOrder, true, true>(lds + RING_OFF, g, S, E);
    }
    xcd_barrier(bar);

    {
        pg8::Gemm g{HID, WDN, M, D, FF}; pg8::StaticOrder S; S.init(M, D, G, bx);
        Epi<6> E{}; E.a.xrb = X1B; E.a.ob = X2B; E.a.ss = SS2;
        pg8::gemm_phase<Epi<6>, pg8::StaticOrder, true, true>(lds + RING_OFF, g, S, E);
    }
    xcd_barrier(bar);

    {
        pg8::StaticOrder S; S.init(M, D, G, bx);
        { pg8::Gemm g{PB, WPE, M, D, PLE}; Epi<7> E{}; E.a.ob = PE; pg8::gemm_phase<Epi<7>, pg8::StaticOrder, true, true>(lds + RING_OFF, g, S, E); }
        { pg8::Gemm g{X2B, WPG, M, D, D}; Epi<8> E{}; E.a.rs = SS2; E.a.gate = PE; E.a.xrb = X2B; E.a.ob = X3B; E.a.ss = SS3; pg8::gemm_phase<Epi<8>, pg8::StaticOrder, true, true>(lds + RING_OFF, g, S, E); }
    }
    xcd_barrier(bar);

    {
        const int gw = bx * NWAVES + wave, NGW = G * NWAVES;
        const bool bad = __hip_atomic_load(ctl + CW_BAR + XB_TMO, RLX_AGENT) != 0u;
        for (int m0 = 4 * gw; m0 < M; m0 += 4 * NGW) {
            v4u xin[4][2]; float rr_[4];
#pragma unroll
            for (int q = 0; q < 4; ++q) { const v4u* xr = (const v4u*)(X3B + (size_t)(m0 + q) * D) + lane; xin[q][0] = xr[0]; xin[q][1] = xr[64]; rr_[q] = SS3[m0 + q]; }
#pragma unroll
            for (int q = 0; q < 4; ++q) {
                float r = __builtin_amdgcn_rsqf(rr_[q] * (1.0f / D) + EPS);
                if (bad) r = __builtin_nanf("");
                f32x4* orow = (f32x4*)(out + (size_t)(m0 + q) * D);
#pragma unroll
                for (int j = 0; j < 2; ++j) {
                    float v[8]; unpack8(xin[q][j], v);
                    const int c0 = 512 * j + 8 * lane;
                    const f32x4 g0 = *(const f32x4*)(norm_final + c0), g1 = *(const f32x4*)(norm_final + c0 + 4);
                    orow[(c0 >> 2)] = (f32x4){v[0] * r * g0[0], v[1] * r * g0[1], v[2] * r * g0[2], v[3] * r * g0[3]};
                    orow[(c0 >> 2) + 1] = (f32x4){v[4] * r * g1[0], v[5] * r * g1[1], v[6] * r * g1[2], v[7] * r * g1[3]};
                }
            }
        }
    }
}

extern "C" void kernel_launch(void* const* d_in, const int* in_sizes, int n_in, void* d_out, int out_size, void* d_ws, size_t ws_size, hipStream_t stream) {
    static int grid = 0;
    if (grid == 0) {
        if (n_in != 16 || out_size != M * D || ws_size < WS_END) { fprintf(stderr, "kernel_launch: unexpected shapes (n_in %d out %d ws %zu)\n", n_in, out_size, ws_size); grid = -1; return; }
        int dev = 0, cus = 0, per_cu = 0;
        if (hipGetDevice(&dev) != hipSuccess || hipDeviceGetAttribute(&cus, hipDeviceAttributeMultiprocessorCount, dev) != hipSuccess) { grid = -1; return; }
        if (hipFuncSetAttribute((const void*)fwd_kernel, hipFuncAttributeMaxDynamicSharedMemorySize, LDS_BYTES) != hipSuccess) { fprintf(stderr, "kernel_launch: hipFuncSetAttribute failed\n"); grid = -1; return; }
        if (hipOccupancyMaxActiveBlocksPerMultiprocessor(&per_cu, (const void*)fwd_kernel, NTHR, LDS_BYTES) != hipSuccess || per_cu < 1) fprintf(stderr, "kernel_launch: occupancy query says %d\n", per_cu);
        (void)hipGetLastError();
        grid = cus;
    }
    if (grid < 0) return;
    (void)hipMemsetAsync((char*)d_ws + WS_CTL, 0, CTL_ZERO_BYTES, stream);
    Args a{};
    for (int i = 0; i < 16; ++i) a.in[i] = (const float*)d_in[i];
    a.out = (float*)d_out; a.ws = (unsigned char*)d_ws;
    hipLaunchKernelGGL(fwd_kernel, dim3(grid), dim3(NTHR), LDS_BYTES, stream, a);
}
```

```cpp
#include <hip/hip_runtime.h>
#include <cstdio>
#include <cstdint>
namespace pg8 {
#define PG8_LAS __attribute__((address_space(3)))
typedef unsigned short bf16_t;
typedef short bf16x8 __attribute__((ext_vector_type(8)));
typedef float f32x4 __attribute__((ext_vector_type(4)));
typedef unsigned u32x4 __attribute__((ext_vector_type(4)));
constexpr int BM = 256, BK = 64, HALF = 128, HTB = HALF * BK * 2  , STAGE_BYTES = 8 * HTB, NXCD = 8, WGM = 8;

__host__ __device__ __forceinline__ int lds_byte(int r, int c) { const int st = (r >> 4) * 2 + (c >> 5), rr = r & 15, cc = c & 31, ob = rr * 64 + cc * 2; return st * 1024 + (ob ^ (((ob >> 9) & 1) << 5)); }
__host__ __device__ __forceinline__ void stage_rc(int b, int& R, int& C) { const int st = b / 1024, sb = b % 1024, swz = sb ^ (((sb >> 9) & 1) << 5); R = (st >> 1) * 16 + swz / 64; C = (st & 1) * 32 + (swz % 64) / 2; }
__host__ __device__ __forceinline__ int perm32(int rho) { const int n = rho >> 4, i = rho & 15; return 8 * (i >> 2) + 4 * n + (i & 3); }

struct Unit { int pm, pn, ks; };
struct Gemm { const bf16_t* A; const bf16_t* Bt; int M, N, K, ld; };

struct StaticOrder {
    int nM, nN, nwg, G, c, rot = 0;
    __host__ __device__ void init(int M, int N, int G_, int c_) { nM = M / BM; nN = N / BM; nwg = nM * nN; G = G_; c = c_; }
    __host__ __device__ bool next(int i, Unit& u) const {
        if (rot != 0 && nwg % G == 0) { const int nr = nwg / G; if (i >= nr) return false; i = (i + rot) % nr; }
        const long L = (long)i * G + c; if (L >= nwg) return false;
        int wgid = (int)L; { const int q = nwg / NXCD, r = nwg % NXCD, xcd = wgid % NXCD, off = wgid / NXCD; wgid = (xcd < r ? xcd * (q + 1) : r * (q + 1) + (xcd - r) * q) + off; }
        const int nig = WGM * nN, gid = wgid / nig, fm = gid * WGM, gsz = (nM - fm) < WGM ? (nM - fm) : WGM;
        u.pm = fm + ((wgid % nig) % gsz); u.pn = (wgid % nig) / gsz; u.ks = 0; return true;
    }
    __device__ __forceinline__ void a_ready(const Unit&) const {}
    __device__ __forceinline__ void done(const Unit&) const {}
};
struct SplitOrder : StaticOrder {
    __host__ __device__ bool next(int i, Unit& u) const { if (!StaticOrder::next(i >> 1, u)) return false; u.ks = i & 1; return true; }
};

__device__ __forceinline__ unsigned cvt_pk_bf16(float lo, float hi) { unsigned r; asm volatile("v_cvt_pk_bf16_f32 %0, %1, %2" : "=v"(r) : "v"(lo), "v"(hi)); return r; }
template <class Epi, class Sched, bool ALIGN_EPI = false, bool SP2 = false>
__device__ __forceinline__ void gemm_phase(PG8_LAS unsigned char* lds, const Gemm g, const Sched& S, const Epi& E) {
    int tid_ = threadIdx.x; asm volatile("" : "+v"(tid_));
    const int tid = tid_, wid = __builtin_amdgcn_readfirstlane(tid >> 6), lane = tid & 63, wr = wid >> 2, wc = wid & 3, fr = lane & 15, fq = lane >> 4;
    const int K = g.K, nt = K / BK, ld = g.ld ? g.ld : K;
    unsigned voffA[2], voffB[2];
#pragma unroll
    for (int i = 0; i < 2; ++i) { int R, C; stage_rc(tid * 16 + i * 8192, R, C); const int Rb = Epi::PERM ? ((R & ~31) + perm32(R & 31)) : R;
        voffA[i] = (unsigned)(R * ld + C) * 2u; voffB[i] = (unsigned)(Rb * ld + C) * 2u; }
    const size_t kstep = (size_t)(BK * 2);
    const size_t hstep = (size_t)HALF * ld * 2;
    const size_t tstep = 2 * hstep;
    const unsigned ldsw = (unsigned)wid * 1024u;
    const int aoff = lds_byte(wr * 64 + fr, fq * 8), boff = lds_byte(wc * 32 + fr, fq * 8);
#define PG8_SA(b, h) (((b) * 2 + (h)) * HTB)
#define PG8_SB(b, h) ((4 + (b) * 2 + (h)) * HTB)
#define PG8_STAGE(bufoff, gbase, voff) do { _Pragma("unroll") for (int _i = 0; _i < 2; ++_i) \
        __builtin_amdgcn_global_load_lds((const unsigned*)((const char*)(gbase) + (voff)[_i]), (PG8_LAS unsigned*)(lds + (bufoff) + ldsw + _i * 8192), 16, 0, 0); } while (0)
#define PG8_LDA(dst, b, h) do { _Pragma("unroll") for (int m = 0; m < 4; ++m) _Pragma("unroll") for (int k = 0; k < 2; ++k) dst[m][k] = *(const PG8_LAS bf16x8*)(lds + PG8_SA(b, h) + aoff + m * 2048 + k * 1024); } while (0)
#define PG8_LDB(dst, b, h) do { _Pragma("unroll") for (int n = 0; n < 2; ++n) _Pragma("unroll") for (int k = 0; k < 2; ++k) dst[n][k] = *(const PG8_LAS bf16x8*)(lds + PG8_SB(b, h) + boff + n * 2048 + k * 1024); } while (0)
#define PG8_MMA(ai, bj, At, Bt) do { __builtin_amdgcn_s_setprio(1); _Pragma("unroll") for (int m = 0; m < 4; ++m) _Pragma("unroll") for (int n = 0; n < 2; ++n) _Pragma("unroll") for (int k = 0; k < 2; ++k) \
        acc[ai][bj][m][n] = __builtin_amdgcn_mfma_f32_16x16x32_bf16(Bt[n][k], At[m][k], acc[ai][bj][m][n], 0, 0, 0); __builtin_amdgcn_s_setprio(0); } while (0)
#define PG8_WAIT_V(n) asm volatile("s_waitcnt vmcnt(" #n ")" ::: "memory")
#define PG8_WAIT_L(n) asm volatile("s_waitcnt lgkmcnt(" #n ")" ::: "memory")
#define PG8_BAR __builtin_amdgcn_s_barrier()
#define PG8_SCHED __builtin_amdgcn_sched_barrier(0)
    Unit cur, nxt; int ui = 0;
    if (!S.next(0, cur)) return;
    f32x4 acc[2][2][4][2];
#pragma unroll
    for (int a = 0; a < 2; ++a)
#pragma unroll
        for (int b = 0; b < 2; ++b)
#pragma unroll
            for (int m = 0; m < 4; ++m)
#pragma unroll
                for (int n = 0; n < 2; ++n) acc[a][b][m][n] = (f32x4){0.f, 0.f, 0.f, 0.f};
    bf16x8 At[4][2], B0[2][2], B1[2][2];
    const char* cA = (const char*)g.A + (size_t)cur.pm * tstep + (size_t)cur.ks * K * 2; const char* cB = (const char*)g.Bt + (size_t)cur.pn * tstep + (size_t)cur.ks * K * 2;
    S.a_ready(cur);
    if constexpr (SP2) {
        PG8_STAGE(PG8_SB(0, 0), cB, voffB); PG8_STAGE(PG8_SB(0, 1), cB + hstep, voffB); PG8_STAGE(PG8_SA(0, 0), cA, voffA); PG8_STAGE(PG8_SA(0, 1), cA + hstep, voffA);
        if (wr == 1) PG8_BAR;
        PG8_WAIT_V(2); PG8_BAR;
        PG8_STAGE(PG8_SB(1, 0), cB + kstep, voffB); PG8_STAGE(PG8_SA(1, 0), cA + kstep, voffA); PG8_STAGE(PG8_SB(1, 1), cB + hstep + kstep, voffB);
        PG8_WAIT_V(6); PG8_BAR;
    } else {
        PG8_STAGE(PG8_SB(0, 0), cB, voffB); PG8_STAGE(PG8_SA(0, 0), cA, voffA); PG8_STAGE(PG8_SB(0, 1), cB + hstep, voffB); PG8_STAGE(PG8_SA(0, 1), cA + hstep, voffA);
        if (wr == 1) PG8_BAR;
        PG8_WAIT_V(4); PG8_BAR;
        PG8_STAGE(PG8_SB(1, 0), cB + kstep, voffB); PG8_STAGE(PG8_SA(1, 0), cA + kstep, voffA); PG8_STAGE(PG8_SB(1, 1), cB + hstep + kstep, voffB);
        PG8_WAIT_V(6); PG8_BAR;
    }
    for (;;) {
        const bool has_next = S.next(ui + 1, nxt);
        const char* nA = has_next ? (const char*)g.A + (size_t)nxt.pm * tstep + (size_t)nxt.ks * K * 2 : cA; const char* nB = has_next ? (const char*)g.Bt + (size_t)nxt.pn * tstep + (size_t)nxt.ks * K * 2 : cB;
#pragma nounroll
        for (int t = 0; t < nt; t += 2) {
            const bool last = (t == nt - 2);
            const char* a1 = cA + (size_t)(t + 1) * kstep;
            const char* a2 = last ? nA : cA + (size_t)(t + 2) * kstep; const char* b2 = last ? nB : cB + (size_t)(t + 2) * kstep;
            const char* a3 = a2 + kstep; const char* b3 = b2 + kstep;
            if (last && has_next) S.a_ready(nxt);
            if constexpr (SP2) {
            PG8_LDB(B0, 0, 0); PG8_LDB(B1, 0, 1); PG8_SCHED; PG8_LDA(At, 0, 0); PG8_STAGE(PG8_SA(1, 1), a1 + hstep, voffA);
            PG8_WAIT_V(8); PG8_WAIT_L(0); PG8_BAR; PG8_MMA(0, 0, At, B0); PG8_MMA(0, 1, At, B1); PG8_BAR; PG8_SCHED;
            PG8_LDA(At, 0, 1); PG8_STAGE(PG8_SB(0, 0), b2, voffB); PG8_STAGE(PG8_SB(0, 1), b2 + hstep, voffB); PG8_STAGE(PG8_SA(0, 0), a2, voffA);
            PG8_WAIT_V(8); PG8_WAIT_L(0); PG8_BAR; PG8_MMA(1, 0, At, B0); PG8_MMA(1, 1, At, B1); PG8_BAR; PG8_SCHED;
            PG8_LDB(B0, 1, 0); PG8_LDB(B1, 1, 1); PG8_SCHED; PG8_LDA(At, 1, 0); PG8_STAGE(PG8_SA(0, 1), a2 + hstep, voffA);
            PG8_WAIT_V(8); PG8_WAIT_L(0); PG8_BAR; PG8_MMA(0, 0, At, B0); PG8_MMA(0, 1, At, B1); PG8_BAR; PG8_SCHED;
            PG8_LDA(At, 1, 1); PG8_STAGE(PG8_SB(1, 0), b3, voffB); PG8_STAGE(PG8_SB(1, 1), b3 + hstep, voffB); PG8_STAGE(PG8_SA(1, 0), a3, voffA);
            PG8_WAIT_V(8); PG8_WAIT_L(0); PG8_BAR; PG8_MMA(1, 0, At, B0); PG8_MMA(1, 1, At, B1); PG8_BAR; PG8_SCHED;
            } else {
            PG8_LDB(B0, 0, 0); PG8_SCHED; PG8_LDA(At, 0, 0); PG8_STAGE(PG8_SA(1, 1), a1 + hstep, voffA);
            PG8_WAIT_L(8); PG8_BAR; PG8_WAIT_L(0); PG8_MMA(0, 0, At, B0); PG8_BAR; PG8_SCHED;
            PG8_LDB(B1, 0, 1); PG8_STAGE(PG8_SB(0, 0), b2, voffB);
            PG8_BAR; PG8_WAIT_L(0); PG8_MMA(0, 1, At, B1); PG8_BAR;
            PG8_LDA(At, 0, 1); PG8_STAGE(PG8_SA(0, 0), a2, voffA);
            PG8_BAR; PG8_WAIT_L(0); PG8_MMA(1, 0, At, B0); PG8_BAR; PG8_SCHED;
            PG8_STAGE(PG8_SB(0, 1), b2 + hstep, voffB);
            PG8_WAIT_V(6); PG8_BAR; PG8_MMA(1, 1, At, B1); PG8_BAR;
            PG8_LDB(B0, 1, 0); PG8_SCHED; PG8_LDA(At, 1, 0); PG8_STAGE(PG8_SA(0, 1), a2 + hstep, voffA);
            PG8_WAIT_L(8); PG8_BAR; PG8_WAIT_L(0); PG8_MMA(0, 0, At, B0); PG8_BAR; PG8_SCHED;
            PG8_LDB(B1, 1, 1); PG8_STAGE(PG8_SB(1, 0), b3, voffB);
            PG8_BAR; PG8_WAIT_L(0); PG8_MMA(0, 1, At, B1); PG8_BAR;
            PG8_LDA(At, 1, 1); PG8_STAGE(PG8_SA(1, 0), a3, voffA);
            PG8_BAR; PG8_WAIT_L(0); PG8_MMA(1, 0, At, B0); PG8_BAR; PG8_SCHED;
            PG8_STAGE(PG8_SB(1, 1), b3 + hstep, voffB);
            PG8_WAIT_V(6); PG8_BAR; PG8_MMA(1, 1, At, B1); PG8_BAR;
            }
        }
        if constexpr (ALIGN_EPI) { if (wr == 0) PG8_BAR; }
        bool keep_acc = false;
        if constexpr (Epi::KSPLIT) { if (cur.ks == 0) { E.mid(acc, cur, wr, wc, fr, fq); keep_acc = true; } }
        if constexpr (!Epi::AFTER_DRAIN) { if (!keep_acc) { E(acc, cur, wr, wc, fr, fq); S.done(cur); } }
        if (!has_next) break;
        if (!keep_acc)
#pragma unroll
        for (int a = 0; a < 2; ++a)
#pragma unroll
            for (int b = 0; b < 2; ++b)
#pragma unroll
                for (int m = 0; m < 4; ++m)
#pragma unroll
                    for (int n = 0; n < 2; ++n) acc[a][b][m][n] = (f32x4){0.f, 0.f, 0.f, 0.f};
        cur = nxt; cA = nA; cB = nB; ++ui;
        if constexpr (ALIGN_EPI) { if (wr == 1) PG8_BAR; }
    }
    PG8_WAIT_V(0);
    if constexpr (!ALIGN_EPI) { if (wr == 0) PG8_BAR; }
    PG8_BAR;
    if constexpr (Epi::AFTER_DRAIN) { E.fused(acc, cur, wr, wc, fr, fq, lds, wid, lane); S.done(cur); }
#undef PG8_SA
#undef PG8_SB
#undef PG8_STAGE
#undef PG8_LDA
#undef PG8_LDB
#undef PG8_MMA
#undef PG8_WAIT_V
#undef PG8_WAIT_L
#undef PG8_BAR
#undef PG8_SCHED
}
}
constexpr int BATCH = 16, SEQ = 4096, D = 1024, M = BATCH * SEQ;
constexpr int NIN = 5632, FF = 2816, PLE = 256;
constexpr int ATTW = 1536, HGW = 2048, GW = 2048;
constexpr float EPS = 1e-6f;
constexpr float QSCALE = 0.125f * 1.4426950408889634f;
constexpr int NWAVES = 8, NTHR = NWAVES * 64;

constexpr size_t MiB = 1u << 20;
constexpr size_t WS_CTL = 0, CTL_ZERO_BYTES = 1 * MiB;
constexpr size_t WS_WIN = 2 * MiB, WS_WGU = 13 * MiB, WS_WDN = 24 * MiB, WS_WOUT = 30 * MiB, WS_WPG = 32 * MiB, WS_WA = 34 * MiB, WS_WB = 35 * MiB, WS_WPE = 36 * MiB;
constexpr size_t WS_RSTD0 = 37 * MiB;
constexpr size_t WS_LSE = 40 * MiB;
constexpr size_t WS_PB = 48 * MiB;
constexpr size_t WS_XB = 80 * MiB;
constexpr size_t WS_YA = 80 * MiB, WS_YB = 80 * MiB;
constexpr size_t WS_ATT = 208 * MiB;
constexpr size_t WS_HG = 400 * MiB;
constexpr size_t WS_GT = 656 * MiB;
constexpr size_t WS_EST = 912 * MiB;
constexpr size_t WS_DCH = 45 * MiB;
constexpr size_t WS_DSEG = 44 * MiB;
constexpr size_t WS_END = 1024 * MiB;
constexpr int CW_BAR = 4096;
constexpr int CW_SS1 = 65536, CW_SS2 = 2 * 65536, CW_SS3 = 3 * 65536;

constexpr int RING_OFF = 0, RING_BYTES = 131072;
constexpr int LDSCTL_OFF = RING_BYTES, MISC_OFF = LDSCTL_OFF + 320;
constexpr int LDS_BYTES = 163840;

#define GAS __attribute__((address_space(1)))
#define LAS __attribute__((address_space(3)))
#define DI __device__ __forceinline__
typedef unsigned short bf16;
typedef unsigned v4u __attribute__((ext_vector_type(4)));
typedef unsigned v2u __attribute__((ext_vector_type(2)));
typedef float f32x4 __attribute__((ext_vector_type(4)));
typedef GAS unsigned gu32;
#define RLX_AGENT __ATOMIC_RELAXED, __HIP_MEMORY_SCOPE_AGENT
#define LDS_WAIT() asm volatile("s_waitcnt lgkmcnt(0)" ::: "memory")
#define VM_WAIT() asm volatile("s_waitcnt vmcnt(0)" ::: "memory")
DI float bflo(unsigned u) { return __builtin_bit_cast(float, u << 16); }
DI float bfhi(unsigned u) { return __builtin_bit_cast(float, u & 0xffff0000u); }
DI float bf2f(bf16 b) { return __builtin_bit_cast(float, (unsigned)b << 16); }
DI float sigmoidf_(float v) { return __builtin_amdgcn_rcpf(1.0f + __expf(-v)); }

#define XB_TMO      128
#define XB_XCNT(j)  (256  + 64 * (j))
#define XB_XSUB(j)  (1280 + 64 * (j))
#define XB_XGEN(j)  (2304 + 64 * (j))
#define XB_TOP      3328
#define XB_TOPGEN   3392
#define XCD_BAR_WORDS 3456
#define XB_SPIN_CAP (1u << 18)

__device__ __forceinline__ unsigned xb_ld(unsigned* p)              { return __hip_atomic_load(p, __ATOMIC_RELAXED, __HIP_MEMORY_SCOPE_AGENT); }
__device__ __forceinline__ unsigned xb_add(unsigned* p, unsigned v) { return __hip_atomic_fetch_add(p, v, __ATOMIC_RELAXED, __HIP_MEMORY_SCOPE_AGENT); }
__device__ __forceinline__ unsigned xb_xcc_id() { return (unsigned)__builtin_amdgcn_s_getreg((3 << 11) | 20) & 0xFu; }
#define XB_SPIN(cond, bar) do { unsigned _sp = 0; while (cond) { __builtin_amdgcn_s_sleep(1); \
    if ((++_sp & 255u) == 0u) { if (xb_ld(&(bar)[XB_TMO])) break; if (_sp > XB_SPIN_CAP) { atomicAdd(&(bar)[XB_TMO], 1u); break; } } } } while (0)

struct XcdBarrier {
    unsigned* bar; unsigned x;
    volatile LAS unsigned* st;
};

__device__ __forceinline__ XcdBarrier xcd_barrier_post(unsigned* bar, volatile LAS unsigned* st) {
    XcdBarrier b; b.bar = bar; b.x = xb_xcc_id(); b.st = st;
    if (threadIdx.x == 0) (void)xb_add(&bar[XB_XCNT(b.x)], 1u);
    return b;
}
__device__ __forceinline__ void xcd_barrier_complete(unsigned* bar, unsigned x, unsigned& nloc, unsigned& nx) {
    const unsigned G = gridDim.x * gridDim.y * gridDim.z;
    unsigned sum, cnt, mine, sp = 0u;
    for (;;) {
        sum = 0u; cnt = 0u; mine = 0u;
#pragma unroll
        for (unsigned j = 0; j < 16; ++j) { const unsigned c = xb_ld(&bar[XB_XCNT(j)]); sum += c; cnt += (c > 0u) ? 1u : 0u; mine = (j == x) ? c : mine; }
        if (sum == G) break;
        __builtin_amdgcn_s_sleep(1);
        if ((++sp & 255u) == 0u) { if (xb_ld(&bar[XB_TMO])) break; if (sp > XB_SPIN_CAP) { atomicAdd(&bar[XB_TMO], 1u); break; } }
    }
    nloc = mine > 0u ? mine : 1u; nx = cnt > 0u ? cnt : 1u;
}

__device__ __forceinline__ void xcd_barrier(const XcdBarrier& b) {
    asm volatile("s_waitcnt vmcnt(0)" ::: "memory");
    __syncthreads();
    if (threadIdx.x == 0) {
        unsigned* bar = b.bar;
        __builtin_amdgcn_s_waitcnt(0);
        unsigned nloc = b.st[0], nx = b.st[1];
        if (nloc == 0u) { xcd_barrier_complete(bar, b.x, nloc, nx); b.st[0] = nloc; b.st[1] = nx; }
        const unsigned old = xb_add(&bar[XB_XSUB(b.x)], 1u);
        const unsigned gen = old / nloc;
        if (old + 1u == (gen + 1u) * nloc) {
            __builtin_amdgcn_fence(__ATOMIC_RELEASE, "agent");
            asm volatile("s_waitcnt vmcnt(0)" ::: "memory");
            const unsigned og = xb_add(&bar[XB_TOP], 1u);
            const unsigned tg = og / nx;
            if (og + 1u == (tg + 1u) * nx) xb_add(&bar[XB_TOPGEN], 1u);
            else XB_SPIN(xb_ld(&bar[XB_TOPGEN]) == tg, bar);
            __builtin_amdgcn_fence(__ATOMIC_ACQUIRE, "agent");
            xb_add(&bar[XB_XGEN(b.x)], 1u);
            asm volatile("s_waitcnt vmcnt(0)" ::: "memory");
        } else {
            XB_SPIN(xb_ld(&bar[XB_XGEN(b.x)]) == gen, bar);
            __builtin_amdgcn_fence(__ATOMIC_ACQUIRE, "agent");
            asm volatile("s_waitcnt vmcnt(0)" ::: "memory");
        }
    }
    __syncthreads();
}

struct EpiArgs {
    const float* rs;
    float* ss;
    const float* xres;
    const bf16* xrb;
    bf16* ob;
    const bf16* gate;
    bf16* att; bf16* hg; bf16* g;
    const float* hg_lb; float* dch;
};
DI void unpack8(const v4u q, float (&f)[8]) { f[0] = bflo(q.x); f[1] = bfhi(q.x); f[2] = bflo(q.y); f[3] = bfhi(q.y); f[4] = bflo(q.z); f[5] = bfhi(q.z); f[6] = bflo(q.w); f[7] = bfhi(q.w); }
DI v4u pack8(const float (&f)[8]) { v4u w; w.x = pg8::cvt_pk_bf16(f[0], f[1]); w.y = pg8::cvt_pk_bf16(f[2], f[3]); w.z = pg8::cvt_pk_bf16(f[4], f[5]); w.w = pg8::cvt_pk_bf16(f[6], f[7]); return w; }

#define ST16(p, v) (*(v4u*)(p) = (v))
DI int arow(int t) { return (t & 3) * (SEQ / 4) + (t >> 2); }
DI float xmax16(float v) { float a = v, b = v; asm volatile("s_nop 1\n\tv_permlane16_swap_b32 %0, %1\n\ts_nop 1" : "+v"(a), "+v"(b)); return fmaxf(a, b); }
DI float xmax32(float v) { float a = v, b = v; asm volatile("s_nop 1\n\tv_permlane32_swap_b32 %0, %1\n\ts_nop 1" : "+v"(a), "+v"(b)); return fmaxf(a, b); }
DI float xadd16(float v) { float a = v, b = v; asm volatile("s_nop 1\n\tv_permlane16_swap_b32 %0, %1\n\ts_nop 1" : "+v"(a), "+v"(b)); return a + b; }
DI float xadd32(float v) { float a = v, b = v; asm volatile("s_nop 1\n\tv_permlane32_swap_b32 %0, %1\n\ts_nop 1" : "+v"(a), "+v"(b)); return a + b; }
template <int N> DI float row_shr(float v) { return __builtin_bit_cast(float, __builtin_amdgcn_update_dpp(0, __builtin_bit_cast(int, v), 0x110 + N, 0xf, 0xf, true)); }
DI float row_last(float v, int lane) { return __builtin_bit_cast(float, __builtin_amdgcn_ds_bpermute((lane | 15) << 2, __builtin_bit_cast(int, v))); }

template <int MODE> struct Epi {
    static constexpr bool PERM = true, AFTER_DRAIN = false;
    static constexpr bool KSPLIT = (MODE == 2);
    EpiArgs a;
    DI void mid(pg8::f32x4 (&acc)[2][2][4][2], const pg8::Unit& u, int wr, int wc, int fr, int fq) const {
        { int l = threadIdx.x & 63; asm volatile("" : "+v"(l)); fr = l & 15; fq = l >> 4; }
        const bf16* gbase = a.gate + (size_t)(u.pm * 256 + wr * 64 + fr) * GW + u.pn * 256 + wc * 32 + 8 * fq;
        v4u ga[4][2], gb[4][2];
        auto load_slice = [&](int ai, int m) {
#pragma unroll
            for (int bj = 0; bj < 2; ++bj) { const bf16* gp = gbase + (size_t)(ai * 128 + m * 16) * GW + bj * 128; ga[m][bj] = *(const v4u*)gp; gb[m][bj] = *(const v4u*)(gp + 1024); }
        };
#pragma unroll
        for (int m = 0; m < 4; ++m) load_slice(0, m);
        __builtin_amdgcn_sched_barrier(0);
#pragma unroll
        for (int ai = 0; ai < 2; ++ai)
#pragma unroll
            for (int m = 0; m < 4; ++m) {
#pragma unroll
                for (int bj = 0; bj < 2; ++bj) {
                    float fa[8], fb[8]; unpack8(ga[m][bj], fa); unpack8(gb[m][bj], fb);
#pragma unroll
                    for (int i = 0; i < 4; ++i) { acc[ai][bj][m][0][i] *= fa[i] * __builtin_amdgcn_rcpf(fmaxf(fb[i], 1e-30f)); acc[ai][bj][m][1][i] *= fa[4 + i] * __builtin_amdgcn_rcpf(fmaxf(fb[4 + i], 1e-30f)); }
                }
                if (ai == 0) { load_slice(1, m); __builtin_amdgcn_sched_barrier(0); }
            }
    }
    DI void hgrn_tile(const pg8::f32x4 (&acc)[2][2][4][2], const pg8::Unit& u, int wr, int wc, int fr, int fq) const {
        const int h = u.pn - 6, chb = wc * 32 + 8 * fq, lane = fq * 16 + fr;
        float lbv[8];
        { const f32x4 a0 = *(const f32x4*)(a.hg_lb + h * 128 + chb), a1 = *(const f32x4*)(a.hg_lb + h * 128 + chb + 4), b0 = *(const f32x4*)(a.hg_lb + 512 + h * 128 + chb), b1 = *(const f32x4*)(a.hg_lb + 512 + h * 128 + chb + 4);
#pragma unroll
            for (int i = 0; i < 4; ++i) { lbv[i] = 1.0f / (1.0f + __expf(b0[i] - a0[i])); lbv[4 + i] = 1.0f / (1.0f + __expf(b1[i] - a1[i])); } }
#pragma unroll
        for (int ai = 0; ai < 2; ++ai) {
            const int rowc = u.pm * 256 + ai * 128 + wr * 64;
#pragma unroll
            for (int n = 0; n < 2; ++n) {
                float qt[4][4], kh[4][4], dtot[4];
#pragma unroll
                for (int i = 0; i < 4; ++i) {
                    const float lb = lbv[4 * n + i];
                    float sc[4], kf[4], rt[4];
#pragma unroll
                    for (int m = 0; m < 4; ++m) {
                        const float f = lb + (1.0f - lb) * sigmoidf_(acc[ai][1][m][n][i]);
                        kf[m] = 1.0f - f;
                        float s = __logf(f);
                        s += row_shr<1>(s); s += row_shr<2>(s); s += row_shr<4>(s); s += row_shr<8>(s);
                        sc[m] = s; rt[m] = row_last(s, lane);
                    }
                    const float tot = (rt[0] + rt[1]) + (rt[2] + rt[3]);
                    float off = 0.f;
#pragma unroll
                    for (int m = 0; m < 4; ++m) { const float b = sc[m] + off; off += rt[m];
                        qt[m][i] = acc[ai][0][m][n][i] * __expf(fminf(b - tot, 80.0f));
                        kh[m][i] = kf[m] * __expf(tot - b); }
                    dtot[i] = __expf(tot);
                }
#pragma unroll
                for (int m = 0; m < 4; ++m) { const int row = rowc + m * 16 + fr; bf16* dst = a.hg + ((size_t)((row >> 12) * 4 + h) * SEQ + (row & (SEQ - 1))) * 128 + chb + 4 * n;
                    v2u wq, wk; wq.x = pg8::cvt_pk_bf16(qt[m][0], qt[m][1]); wq.y = pg8::cvt_pk_bf16(qt[m][2], qt[m][3]); wk.x = pg8::cvt_pk_bf16(kh[m][0], kh[m][1]); wk.y = pg8::cvt_pk_bf16(kh[m][2], kh[m][3]);
                    *(v2u*)dst = wq; *(v2u*)(dst + (size_t)M * 512) = wk; }
                if (fr == 0) { float* dp = a.dch + ((size_t)(rowc >> 6) * 4 + h) * 128 + chb + 4 * n;
                    *(f32x4*)dp = (f32x4){dtot[0], dtot[1], dtot[2], dtot[3]}; }
            }
        }
    }
    DI void operator()(const pg8::f32x4 (&acc)[2][2][4][2], const pg8::Unit& u, int wr, int wc, int fr, int fq) const {
        { int l = threadIdx.x & 63; asm volatile("" : "+v"(l)); fr = l & 15; fq = l >> 4; }
        const int row0 = u.pm * 256 + wr * 64 + fr;
        const int colt = u.pn * 256 + wc * 32 + 8 * fq;
        int kind = 0;
        if (MODE == 1) kind = (u.pn < 2) ? 0 : (u.pn < 6) ? 1 : (u.pn < 10) ? 5 : (u.pn < 12) ? 2 : (u.pn < 14) ? 3 : 4;
        if constexpr (MODE == 1) { if (kind == 5) { hgrn_tile(acc, u, wr, wc, fr, fq); return; } }
        if constexpr (MODE == 2 || MODE == 4 || MODE == 5 || MODE == 6 || MODE == 8) {
            float rsv[2][4];
            if constexpr (MODE == 4 || MODE == 5 || MODE == 8) {
#pragma unroll
                for (int ai = 0; ai < 2; ++ai)
#pragma unroll
                    for (int m = 0; m < 4; ++m) rsv[ai][m] = a.rs[row0 + ai * 128 + m * 16];
            }
            if constexpr (MODE == 5) {
                const int hcol = u.pn * 128 + wc * 32 + 8 * fq;
#pragma unroll
                for (int ai = 0; ai < 2; ++ai)
#pragma unroll
                    for (int m = 0; m < 4; ++m) {
                        const int row = row0 + ai * 128 + m * 16;
                        const float r = __builtin_amdgcn_rsqf(rsv[ai][m] * (1.0f / D) + EPS);
                        float v[8];
#pragma unroll
                        for (int i = 0; i < 4; ++i) {
                            const float g0 = acc[ai][0][m][0][i] * r, u0 = acc[ai][1][m][0][i] * r, g1 = acc[ai][0][m][1][i] * r, u1 = acc[ai][1][m][1][i] * r;
                            v[i] = g0 * sigmoidf_(g0) * u0; v[4 + i] = g1 * sigmoidf_(g1) * u1;
                        }
                        ST16(a.ob + (size_t)row * FF + hcol, pack8(v));
                    }
            } else {
                v4u xq[4][2], eq[4][2];
                auto load_slice = [&](int ai, int m) {
#pragma unroll
                    for (int bj = 0; bj < 2; ++bj) {
                        const int row = row0 + ai * 128 + m * 16, col = colt + bj * 128;
                        if constexpr (MODE == 2) xq[m][bj] = *(const v4u*)(a.gate + (size_t)row * GW + 1024 + col);
                        else xq[m][bj] = *(const v4u*)(a.xrb + (size_t)row * D + col);
                        if constexpr (MODE == 8) eq[m][bj] = *(const v4u*)(a.gate + (size_t)row * D + col);
                    }
                };
#pragma unroll
                for (int m = 0; m < 4; ++m) load_slice(0, m);
#pragma unroll
                for (int ai = 0; ai < 2; ++ai)
#pragma unroll
                    for (int m = 0; m < 4; ++m) {
                        const int row = row0 + ai * 128 + m * 16;
                        v4u res[2];
                        float r = 0.f, s = 0.f;
                        if constexpr (MODE == 8) r = __builtin_amdgcn_rsqf(rsv[ai][m] * (1.0f / D) + EPS);
                        if constexpr (MODE == 4) r = rsv[ai][m];
#pragma unroll
                        for (int bj = 0; bj < 2; ++bj) {
                            float xr[8], v[8];
                            unpack8(xq[m][bj], xr);
#pragma unroll
                            for (int i = 0; i < 4; ++i) { v[i] = acc[ai][bj][m][0][i]; v[4 + i] = acc[ai][bj][m][1][i]; }
                            if constexpr (MODE == 2) {
#pragma unroll
                                for (int i = 0; i < 8; ++i) v[i] *= fmaxf(xr[i], 1e-30f);
                            } else {
                                if constexpr (MODE == 4) {
#pragma unroll
                                    for (int i = 0; i < 8; ++i) xr[i] *= r;
                                }
                                if constexpr (MODE == 8) {
                                    float e[8]; unpack8(eq[m][bj], e);
#pragma unroll
                                    for (int i = 0; i < 8; ++i) v[i] = e[i] * sigmoidf_(v[i] * r);
                                }
#pragma unroll
                                for (int i = 0; i < 8; ++i) { v[i] += xr[i]; s += v[i] * v[i]; }
                            }
                            res[bj] = pack8(v);
                        }
                        if (ai == 0) load_slice(1, m);
#pragma unroll
                        for (int bj = 0; bj < 2; ++bj) *(v4u*)(a.ob + (size_t)row * D + colt + bj * 128) = res[bj];
                        if constexpr (MODE != 2) { s = xadd32(xadd16(s)); if (fq == 0) atomicAdd(a.ss + row, s); }
                    }
            }
            return;
        }
#pragma unroll
        for (int ai = 0; ai < 2; ++ai)
#pragma unroll
            for (int m = 0; m < 4; ++m) {
                const int row = row0 + ai * 128 + m * 16;
                if constexpr (MODE == 1) {
#pragma unroll
                    for (int bj = 0; bj < 2; ++bj) {
                        const int col = colt + bj * 128;
                        float v[8];
#pragma unroll
                        for (int i = 0; i < 4; ++i) { v[i] = acc[ai][bj][m][0][i]; v[4 + i] = acc[ai][bj][m][1][i]; }
                        bf16* dst;
                        const int bb = row >> 12, tt_ = row & (SEQ - 1);
                        if (kind <= 1) {
                            if (kind == 0) {
#pragma unroll
                                for (int i = 0; i < 8; ++i) v[i] *= QSCALE;
                            }
                            const int which = col >> 9, cw = col & 511;
                            dst = a.att + (size_t)which * ((size_t)M * 512) + ((size_t)(bb * 8 + (cw >> 6)) * SEQ + arow(tt_)) * 64 + (cw & 63);
                        } else if (kind == 2 || kind == 3) {
                            if (kind == 3) {
#pragma unroll
                                for (int i = 0; i < 8; ++i) v[i] = v[i] * sigmoidf_(v[i]);
                            }
                            const int cw = (col - 2560) & 511;
                            dst = a.hg + (size_t)kind * ((size_t)M * 512) + ((size_t)(bb * 4 + (cw >> 7)) * SEQ + tt_) * 128 + (cw & 127);
                        } else {
#pragma unroll
                            for (int i = 0; i < 8; ++i) v[i] = sigmoidf_(v[i]);
                            dst = a.g + (size_t)row * GW + (col - 3584);
                        }
                        ST16(dst, pack8(v));
                    }
                } else {
#pragma unroll
                    for (int bj = 0; bj < 2; ++bj) {
                        const int col = colt + bj * 128;
                        float v[8];
#pragma unroll
                        for (int i = 0; i < 4; ++i) { v[i] = acc[ai][bj][m][0][i]; v[4 + i] = acc[ai][bj][m][1][i]; }
                        *(v4u*)(a.ob + (size_t)row * D + col) = pack8(v);
                    }
                }
            }
    }
};

DI float wave_sum(float v) {
#pragma unroll
    for (int o = 1; o < 64; o <<= 1) v += __shfl_xor(v, o);
    return v;
}
DI void p0_transpose_item(const float* W, int K, int N, const float* gain, bf16* WT, int GU, LAS float* scr, int item, int lane, int pitch = 0, int coff = 0) {
    if (pitch == 0) pitch = K;
    const int nblk = N / 32, kb = item / nblk, nb = item % nblk, k0 = 64 * kb, n0 = 32 * nb;
    int s0 = n0;
    if (GU == 1) { const int tile = n0 >> 8, j = n0 & 255; s0 = (j < 128) ? tile * 128 + j : FF + tile * 128 + (j - 128); }
    if (GU == 2) { const int tile = n0 >> 8, j = n0 & 255; if (tile >= 6 && tile < 10) s0 = (j < 128) ? 1536 + (tile - 6) * 128 + j : 2048 + (tile - 6) * 128 + (j - 128); }
    float wv[32];
#pragma unroll
    for (int i = 0; i < 32; ++i) wv[i] = W[(size_t)(k0 + 2 * i + (lane >> 5)) * N + s0 + (lane & 31)];
    if (gain) {
#pragma unroll
        for (int i = 0; i < 32; ++i) wv[i] *= gain[k0 + 2 * i + (lane >> 5)];
    }
#pragma unroll
    for (int i = 0; i < 32; ++i) scr[(2 * i + (lane >> 5)) * 33 + (lane & 31)] = wv[i];
    LDS_WAIT(); asm volatile("" ::: "memory");
    const int c = lane & 7;
#pragma unroll
    for (int j = 0; j < 4; ++j) { const int n = (lane >> 3) + 8 * j; const LAS float* s = scr + (8 * c) * 33 + n;
        v4u o; o.x = pg8::cvt_pk_bf16(s[0 * 33], s[1 * 33]); o.y = pg8::cvt_pk_bf16(s[2 * 33], s[3 * 33]); o.z = pg8::cvt_pk_bf16(s[4 * 33], s[5 * 33]); o.w = pg8::cvt_pk_bf16(s[6 * 33], s[7 * 33]);
        *(GAS v4u*)(WT + (size_t)(n0 + n) * pitch + coff + k0 + 8 * c) = o; }
    LDS_WAIT(); asm volatile("" ::: "memory");
}

struct Args { const float* in[16]; float* out; unsigned char* ws; };

typedef short s16x4 __attribute__((ext_vector_type(4)));
typedef float f32x16 __attribute__((ext_vector_type(16)));
typedef float f32x2_t __attribute__((ext_vector_type(2))); typedef __bf16 bf16x2_t __attribute__((ext_vector_type(2)));
typedef short v4i16_t __attribute__((ext_vector_type(4)));
DI unsigned cvtpk_s(float lo, float hi) { f32x2_t v = {lo, hi}; bf16x2_t b = __builtin_convertvector(v, bf16x2_t); return __builtin_bit_cast(unsigned, b); }
DI s16x4 vtr(const LAS unsigned char* p) { return __builtin_bit_cast(s16x4, __builtin_amdgcn_ds_read_tr16_b64_v4i16((LAS v4i16_t*)p)); }
DI int crow(int i, int hh) { return (i & 3) + 8 * (i >> 2) + 4 * hh; }
DI s16x4 vtr_asm(unsigned addr) { s16x4 r; asm volatile("ds_read_b64_tr_b16 %0, %1" : "=v"(r) : "v"(addr) : "memory"); return r; }
#define TR_WAIT4(a, b, c, d) do { asm volatile("s_waitcnt lgkmcnt(0)" : "+v"(a), "+v"(b), "+v"(c), "+v"(d) :: "memory"); __builtin_amdgcn_sched_barrier(0); } while (0)
DI pg8::bf16x8 pack_step(const f32x16& x, int s) {
    v4u p; p.x = cvtpk_s(x[8 * s], x[8 * s + 1]); p.y = cvtpk_s(x[8 * s + 2], x[8 * s + 3]); p.z = cvtpk_s(x[8 * s + 4], x[8 * s + 5]); p.w = cvtpk_s(x[8 * s + 6], x[8 * s + 7]);
    return __builtin_bit_cast(pg8::bf16x8, p);
}
#define MFMA32(a, b, c) __builtin_amdgcn_mfma_f32_32x32x16_bf16((a), (b), (c), 0, 0, 0)
#define HBAR() do { asm volatile("s_waitcnt lgkmcnt(0)" ::: "memory"); __builtin_amdgcn_s_barrier(); asm volatile("" ::: "memory"); } while (0)

#define MFMA16(a, b, c) __builtin_amdgcn_mfma_f32_16x16x32_bf16((a), (b), (c), 0, 0, 0)
struct A16Blk { int d, blk_start, res; };
DI A16Blk a16_blk(int s, int sp) {
    const int pass = s >> 4, bi = s & 15, d = (pass == 0) ? 16 : (pass == 1) ? 4 : 1, bpr = 16 / d;
    A16Blk B; B.d = d; B.res = bi / bpr; B.blk_start = sp * (2048 / d) + (bi % bpr) * 128; return B;
}
DI void a16_dma(LAS unsigned char* kbuf, LAS unsigned char* vbuf, LAS unsigned char* qbuf, const bf16* Qh, const bf16* Kh, const bf16* Vh, const A16Blk& B, int wave, int lane) {
    const int l0 = B.blk_start - 128 + wave * 32 + (lane >> 3) + ((B.blk_start == 0 && wave < 4) ? 128 : 0);
    const bf16* kp = Kh + (size_t)(unsigned)(arow(l0 * B.d + B.res) * 64);
    const bf16* vp = Vh + (size_t)(unsigned)(arow(l0 * B.d + B.res) * 64);
    const size_t pstep = (size_t)(B.d * 2 * 64);
#pragma unroll
    for (int i = 0; i < 4; ++i) {
        const int pc = wave * 4 + i, sw = ((i & 1) * 4 + (lane >> 4)) & 7;
        const int ck = (lane & 7) ^ sw;
        const int cv = ((((lane & 7) >> 1) ^ (sw & 3)) << 1) + (lane & 1);
        __builtin_amdgcn_global_load_lds((const unsigned*)(kp + i * pstep + ck * 8), (LAS unsigned*)(kbuf + pc * 1024), 16, 0, 0);
        __builtin_amdgcn_global_load_lds((const unsigned*)(vp + i * pstep + cv * 8), (LAS unsigned*)(vbuf + pc * 1024), 16, 0, 0);
    }
#pragma unroll
    for (int i = 0; i < 2; ++i) {
        const int qr = i * 8 + (lane >> 3);
        const unsigned rowq = (unsigned)arow((B.blk_start + 16 * wave + qr) * B.d + B.res) * 64u;
        __builtin_amdgcn_global_load_lds((const unsigned*)(Qh + rowq + (((lane & 7) ^ ((qr >> 1) & 7)) << 3)), (LAS unsigned*)(qbuf + i * 1024), 16, 0, 0);
    }
}
DI void attn16_unit(LAS unsigned char* lds, const bf16* ATT, bf16* Y, float* LSE, int b, int h, int sp, int tid) {
    const int lane = tid & 63, wave = __builtin_amdgcn_readfirstlane(tid >> 6);
    const int c = lane & 15, g = lane >> 4, tq4 = c >> 2, tp = c & 3;
    const bf16* Qh = ATT + (size_t)(b * 8 + h) * SEQ * 64; const bf16* Kh = Qh + (size_t)M * 512; const bf16* Vh = Kh + (size_t)M * 512;
    constexpr int NS = 48;
    { const A16Blk B0 = a16_blk(0, sp); a16_dma(lds, lds + 32768, lds + RING_BYTES + wave * 2048, Qh, Kh, Vh, B0, wave, lane); }
    VM_WAIT();
#pragma unroll 2
    for (int s = 0; s < NS; ++s) {
        const A16Blk B = a16_blk(s, sp);
        const int bs = s & 1, pass = s >> 4;
        LAS unsigned char* kb = lds + bs * 65536; LAS unsigned char* vb = kb + 32768;
        LAS unsigned char* qs = lds + RING_BYTES + bs * 16384 + wave * 2048;
        if (s == 16 || s == 32) {
            VM_WAIT(); HBAR();
            __builtin_amdgcn_fence(__ATOMIC_ACQUIRE, "agent");
            VM_WAIT();
        }
        asm volatile("s_waitcnt vmcnt(3)" ::: "memory"); HBAR();
        const size_t rowb = (size_t)b * SEQ + B.res;
        const int q0 = B.blk_start + 16 * wave;
        bf16* ybase = Y + rowb * 1024 + h * 64 + (lane & 7) * 8;
        const size_t tokc = rowb + (size_t)((q0 + c) * B.d);
        v4u prw0, prw1; float lp;
        if (pass > 0) {
            asm volatile("global_load_dwordx4 %0, %1, off" : "=v"(prw0) : "v"(ybase + (size_t)((q0 + (lane >> 3)) * B.d) * 1024) : "memory");
            asm volatile("global_load_dwordx4 %0, %1, off" : "=v"(prw1) : "v"(ybase + (size_t)((q0 + (lane >> 3) + 8) * B.d) * 1024) : "memory");
            asm volatile("global_load_dword %0, %1, off" : "=v"(lp) : "v"(LSE + tokc * 8 + h) : "memory");
        } else { prw0 = (v4u){0u, 0u, 0u, 0u}; prw1 = prw0; lp = 0.f; }
        { const A16Blk Bn = a16_blk(s + 1 < NS ? s + 1 : s, sp);
            a16_dma(lds + (bs ^ 1) * 65536, lds + (bs ^ 1) * 65536 + 32768, lds + RING_BYTES + (bs ^ 1) * 16384 + wave * 2048, Qh, Kh, Vh, Bn, wave, lane); }
        pg8::bf16x8 qf[2];
#pragma unroll
        for (int sx = 0; sx < 2; ++sx) qf[sx] = *(const LAS pg8::bf16x8*)(qs + c * 128 + (((4 * sx + g) ^ ((c >> 1) & 7)) << 4));
        f32x4 S[10];
#pragma unroll
        for (int kt = 0; kt < 9; ++kt) {
            S[kt] = (f32x4){0.f, 0.f, 0.f, 0.f};
            const int key = 16 * wave + 16 * kt + c;
#pragma unroll
            for (int sx = 0; sx < 2; ++sx) {
                const pg8::bf16x8 kf = *(const LAS pg8::bf16x8*)(kb + key * 128 + (((4 * sx + g) ^ ((key >> 1) & 7)) << 4));
                S[kt] = MFMA16(kf, qf[sx], S[kt]);
            }
        }
        S[9] = (f32x4){0.f, 0.f, 0.f, 0.f};
        const float NEG = -1e30f;
#pragma unroll
        for (int i = 0; i < 4; ++i) { const int kr = 4 * g + i; S[0][i] = (kr >= c) ? S[0][i] : NEG; S[8][i] = (kr <= c) ? S[8][i] : NEG; }
        if (B.blk_start == 0) {
#pragma unroll
            for (int kt = 0; kt < 8; ++kt) if (wave + kt < 8) S[kt] = (f32x4){NEG, NEG, NEG, NEG};
        }
        float mx = NEG;
#pragma unroll
        for (int kt = 0; kt < 9; ++kt)
#pragma unroll
            for (int i = 0; i < 4; ++i) mx = fmaxf(mx, S[kt][i]);
        mx = xmax16(mx); mx = xmax32(mx);
#pragma unroll
        for (int kt = 0; kt < 9; ++kt)
#pragma unroll
            for (int i = 0; i < 4; ++i) S[kt][i] = __builtin_amdgcn_exp2f(S[kt][i] - mx);
        f32x4 O[4], Lsum = (f32x4){0.f, 0.f, 0.f, 0.f};
        const pg8::bf16x8 ones = __builtin_bit_cast(pg8::bf16x8, (v4u){0x3f803f80u, 0x3f803f80u, 0x3f803f80u, 0x3f803f80u});
#pragma unroll
        for (int t = 0; t < 4; ++t) O[t] = (f32x4){0.f, 0.f, 0.f, 0.f};
        const unsigned vb32 = (unsigned)(size_t)vb;
#define V16A(k_, t_) (vb32 + (k_) * 128 + (((t_) ^ (((k_) >> 1) & 3)) << 5) + 8 * tp)
        s16x4 vl[2][4], vh[2][4];
        { const int klo = 16 * wave + 4 * g + tq4, khi = klo + 16;
#pragma unroll
            for (int t = 0; t < 4; ++t) { vl[0][t] = vtr_asm(V16A(klo, t)); vh[0][t] = vtr_asm(V16A(khi, t)); } }
#pragma unroll
        for (int j = 0; j < 5; ++j) {
            v4u pw; pw.x = cvtpk_s(S[2 * j][0], S[2 * j][1]); pw.y = cvtpk_s(S[2 * j][2], S[2 * j][3]); pw.z = cvtpk_s(S[2 * j + 1][0], S[2 * j + 1][1]); pw.w = cvtpk_s(S[2 * j + 1][2], S[2 * j + 1][3]);
            const pg8::bf16x8 pb = __builtin_bit_cast(pg8::bf16x8, pw);
            if (j < 4) {
                const int klo = 16 * wave + 32 * (j + 1) + 4 * g + tq4, khi = (j + 1 < 4) ? klo + 16 : klo;
#pragma unroll
                for (int t = 0; t < 4; ++t) { vl[(j + 1) & 1][t] = vtr_asm(V16A(klo, t)); vh[(j + 1) & 1][t] = vtr_asm(V16A(khi, t)); }
                asm volatile("s_waitcnt lgkmcnt(8)" : "+v"(vl[j & 1][0]), "+v"(vh[j & 1][0]), "+v"(vl[j & 1][1]), "+v"(vh[j & 1][1]), "+v"(vl[j & 1][2]), "+v"(vh[j & 1][2]), "+v"(vl[j & 1][3]), "+v"(vh[j & 1][3]) :: "memory");
            } else
                asm volatile("s_waitcnt lgkmcnt(0)" : "+v"(vl[j & 1][0]), "+v"(vh[j & 1][0]), "+v"(vl[j & 1][1]), "+v"(vh[j & 1][1]), "+v"(vl[j & 1][2]), "+v"(vh[j & 1][2]), "+v"(vl[j & 1][3]), "+v"(vh[j & 1][3]) :: "memory");
            __builtin_amdgcn_sched_barrier(0);
#pragma unroll
            for (int t = 0; t < 4; ++t) O[t] = MFMA16(__builtin_shufflevector(vl[j & 1][t], vh[j & 1][t], 0, 1, 2, 3, 4, 5, 6, 7), pb, O[t]);
            Lsum = MFMA16(ones, pb, Lsum);
        }
#undef V16A
        const float l = Lsum[0];
        asm volatile("s_waitcnt vmcnt(10)" : "+v"(prw0), "+v"(prw1), "+v"(lp) :: "memory");
        float lse = mx + __builtin_amdgcn_logf(l);
        const float invl = __builtin_amdgcn_rcpf(l);
        const bool mrg = pass > 0;
        const float lpp = mrg ? lp : lse;
        const float mm = fmaxf(lpp, lse), ep = __builtin_amdgcn_exp2f(lpp - mm), en = __builtin_amdgcn_exp2f(lse - mm), inv = __builtin_amdgcn_rcpf(ep + en);
        const float wp = mrg ? ep * inv : 0.f, wn = mrg ? en * inv * invl : invl;
        lse = mrg ? mm + __builtin_amdgcn_logf(ep + en) : lse;
        LDS_WAIT();
        { const int qr = (lane >> 3); *(LAS v4u*)(qs + qr * 128 + (((lane & 7) ^ (qr & 7)) << 4)) = prw0; *(LAS v4u*)(qs + (qr + 8) * 128 + (((lane & 7) ^ (qr & 7)) << 4)) = prw1; }
        LDS_WAIT();
#pragma unroll
        for (int t = 0; t < 4; ++t) {
            LAS unsigned char* ap = qs + c * 128 + (((2 * t + (g >> 1)) ^ (c & 7)) << 4) + 8 * (g & 1);
            const v2u pq = *(const LAS v2u*)ap;
            const float o0 = __builtin_fmaf(wp, bflo(pq.x), O[t][0] * wn), o1 = __builtin_fmaf(wp, bfhi(pq.x), O[t][1] * wn), o2 = __builtin_fmaf(wp, bflo(pq.y), O[t][2] * wn), o3 = __builtin_fmaf(wp, bfhi(pq.y), O[t][3] * wn);
            v2u w; w.x = cvtpk_s(o0, o1); w.y = cvtpk_s(o2, o3);
            *(LAS v2u*)ap = w;
        }
        LDS_WAIT();
        v4u ow[2];
#pragma unroll
        for (int j = 0; j < 2; ++j) { const int qr = (lane >> 3) + 8 * j; ow[j] = *(const LAS v4u*)(qs + qr * 128 + (((lane & 7) ^ (qr & 7)) << 4)); }
#pragma unroll
        for (int j = 0; j < 2; ++j) *(v4u*)(ybase + (size_t)((q0 + (lane >> 3) + 8 * j) * B.d) * 1024) = ow[j];
        if (g == 0) LSE[tokc * 8 + h] = lse;
    }
    VM_WAIT(); HBAR();
}

constexpr int H_STAGE = 49152, H_QT = 0, H_KH = 16384, H_VV = 32768, H_ST = 98304, H_PSS = RING_BYTES + 1024, H_OB = RING_BYTES + 4096;
constexpr int NSEG = 4, SEGL = 16, NHU = 64 * NSEG;
DI int seg_start(int seg) { return seg * SEGL; }
DI int seg_len(int seg) { return (seg == NSEG - 1) ? 64 - (NSEG - 1) * SEGL : SEGL; }
DI int fsw(int s) { return ((s & 3) << 2) | ((s >> 2) & 3); }
DI pg8::bf16x8 rowfrag(const LAS unsigned char* base, int row, int ks, int hh) { return *(const LAS pg8::bf16x8*)(base + row * 256 + (((2 * ks + hh) ^ fsw(row)) << 4)); }

template <int NIMG> DI void hgrn_dma(LAS unsigned char* stg, const bf16* HG, size_t row0, int h, int wave, int lane) {
    const int t4 = lane >> 4, pc = lane & 15;
#pragma unroll
    for (int i = 0; i < 2 * NIMG; ++i) {
        const int p = wave * 2 * NIMG + i;
        const int img = p >> 4, pp = p & 15, t = pp * 4 + t4;
        const int im = (NIMG == 3) ? img : img + 1;
        int c;
        if (im < 2) c = pc ^ fsw(t); else c = (((pc >> 2) ^ (t & 3)) << 2) + (pc & 3);
        const bf16* src = HG + (size_t)im * ((size_t)M * 512) + ((size_t)((row0 >> 12) * 4 + h) * SEQ + (row0 & (SEQ - 1)) + t) * 128 + c * 8;
        __builtin_amdgcn_global_load_lds((const unsigned*)src, (LAS unsigned*)(stg + im * 16384 + pp * 1024), 16, 0, 0);
    }
}

DI void hgrn_vfrags(const LAS unsigned char* stg, pg8::bf16x8 (&vf)[2][2], int vt, int hh, int tq, int tp, int tblk) {
    const unsigned vb32 = (unsigned)(size_t)stg + H_VV;
    const int k0 = 4 * hh + tq;
#define HVA(k_) (vb32 + (k_) * 256 + ((vt ^ ((k_) & 3)) << 6) + 32 * tblk + 8 * tp)
    s16x4 a0 = vtr_asm(HVA(k0)), a1 = vtr_asm(HVA(k0 + 8)), a2 = vtr_asm(HVA(k0 + 16)), a3 = vtr_asm(HVA(k0 + 24));
    s16x4 a4 = vtr_asm(HVA(k0 + 32)), a5 = vtr_asm(HVA(k0 + 40)), a6 = vtr_asm(HVA(k0 + 48)), a7 = vtr_asm(HVA(k0 + 56));
#undef HVA
    asm volatile("s_waitcnt lgkmcnt(0)" : "+v"(a0), "+v"(a1), "+v"(a2), "+v"(a3), "+v"(a4), "+v"(a5), "+v"(a6), "+v"(a7) :: "memory"); __builtin_amdgcn_sched_barrier(0);
    vf[0][0] = __builtin_shufflevector(a0, a1, 0, 1, 2, 3, 4, 5, 6, 7); vf[0][1] = __builtin_shufflevector(a2, a3, 0, 1, 2, 3, 4, 5, 6, 7);
    vf[1][0] = __builtin_shufflevector(a4, a5, 0, 1, 2, 3, 4, 5, 6, 7); vf[1][1] = __builtin_shufflevector(a6, a7, 0, 1, 2, 3, 4, 5, 6, 7);
}
DI void hgrn_update(const LAS unsigned char* stg, f32x16 (&Sacc)[2], const pg8::bf16x8 (&vf)[2][2], int tt, int hh, int tq, int tp, int tblk) {
    const unsigned kb32 = (unsigned)(size_t)stg + H_KH;
    const int k0 = 4 * hh + tq;
#pragma unroll
    for (int j = 0; j < 2; ++j) {
        const int kt = 2 * tt + j, cch = 4 * kt + 2 * tblk + (tp >> 1);
#define HKA(k_) (kb32 + (k_) * 256 + ((cch ^ fsw(k_)) << 4) + 8 * (tp & 1))
#pragma unroll
        for (int st = 0; st < 2; ++st) {
            s16x4 a0 = vtr_asm(HKA(k0 + 32 * st)), a1 = vtr_asm(HKA(k0 + 32 * st + 8)), a2 = vtr_asm(HKA(k0 + 32 * st + 16)), a3 = vtr_asm(HKA(k0 + 32 * st + 24));
            TR_WAIT4(a0, a1, a2, a3);
            Sacc[j] = MFMA32(vf[st][0], __builtin_shufflevector(a0, a1, 0, 1, 2, 3, 4, 5, 6, 7), Sacc[j]);
            Sacc[j] = MFMA32(vf[st][1], __builtin_shufflevector(a2, a3, 0, 1, 2, 3, 4, 5, 6, 7), Sacc[j]);
        }
#undef HKA
    }
}

DI void hgrn_dmaA(LAS unsigned char* lds, int st, const bf16* HG, const float* DCH, size_t row0, int h, int wave, int lane) {
    hgrn_dma<2>(lds + st * 32768, HG, row0, h, wave, lane);
    if (wave < 2) __builtin_amdgcn_global_load_lds((const unsigned*)(DCH + ((row0 >> 6) * 4 + h) * 128 + wave * 64 + lane), (LAS unsigned*)(lds + 114688 + st * 512 + wave * 256), 4, 0, 0);
}
DI void hgrn_passA(LAS unsigned char* lds, const bf16* HG, const float* DCH, float* EST, float* DSEG, int bx, int G, int tid) {
    const int lane = tid & 63, wave = __builtin_amdgcn_readfirstlane(tid >> 6), vt = wave >> 1, tt = wave & 1;
    const int r = lane & 31, hh = lane >> 5, i16 = lane & 15, tq = i16 >> 2, tp = i16 & 3, tblk = (lane >> 4) & 1;
    for (int u = bx; u < NHU; u += G) {
        const int bh = u & 63, seg = u >> 6, h = bh & 3, sid = bh * NSEG + seg;
        if (seg == NSEG - 1) continue;
        const int nci = seg_len(seg);
        const size_t rowb = (size_t)(bh >> 2) * SEQ + seg_start(seg) * 64;
        f32x16 Sacc[2]; float dprod[2] = {1.f, 1.f};
#pragma unroll
        for (int j = 0; j < 2; ++j)
#pragma unroll
            for (int i = 0; i < 16; ++i) Sacc[j][i] = 0.f;
        hgrn_dmaA(lds, 0, HG, DCH, rowb, h, wave, lane);
        hgrn_dmaA(lds, 1, HG, DCH, rowb + 64, h, wave, lane);
        if (wave < 2) asm volatile("s_waitcnt vmcnt(5)" ::: "memory"); else asm volatile("s_waitcnt vmcnt(4)" ::: "memory");
        HBAR();
        int st = 0;
        for (int ci = 0; ci < nci; ++ci) {
            LAS unsigned char* stg = lds + st * 32768;
            const LAS float* DV = (const LAS float*)(lds + 114688 + st * 512);
            const int st2 = (st == 0) ? 2 : st - 1;
            if (ci + 2 < nci) hgrn_dmaA(lds, st2, HG, DCH, rowb + (size_t)(ci + 2) * 64, h, wave, lane);
#pragma unroll
            for (int j = 0; j < 2; ++j) { const float dk = DV[32 * (2 * tt + j) + r]; dprod[j] *= dk;
#pragma unroll
                for (int i = 0; i < 16; ++i) Sacc[j][i] *= dk; }
            pg8::bf16x8 vf[2][2];
            hgrn_vfrags(stg, vf, vt, hh, tq, tp, tblk);
            hgrn_update(stg, Sacc, vf, tt, hh, tq, tp, tblk);
            if (ci + 2 < nci) { if (wave < 2) asm volatile("s_waitcnt vmcnt(5)" ::: "memory"); else asm volatile("s_waitcnt vmcnt(4)" ::: "memory"); } else VM_WAIT();
            HBAR();
            st = (st == 2) ? 0 : st + 1;
        }
#pragma unroll
        for (int j = 0; j < 2; ++j)
#pragma unroll
            for (int i = 0; i < 16; ++i) EST[(size_t)sid * 16384 + (32 * vt + crow(i, hh)) * 128 + 32 * (2 * tt + j) + r] = Sacc[j][i];
        if (vt == 0 && hh == 0) { DSEG[sid * 128 + 64 * tt + r] = dprod[0]; DSEG[sid * 128 + 64 * tt + 32 + r] = dprod[1]; }
    }
}
DI void hgrn_passC(LAS unsigned char* lds, const bf16* HG, const float* DCH, const float* hg_norm, const float* SST, const float* DSEG, bf16* YB, int bx, int G, int tid) {
    asm volatile("" : "+v"(tid));
    const int lane = tid & 63, wave = __builtin_amdgcn_readfirstlane(tid >> 6), vt = wave >> 1, tt = (wave ^ (wave >> 2)) & 1;
    const int r = lane & 31, hh = lane >> 5, i16 = lane & 15, tq = i16 >> 2, tp = i16 & 3, tblk = (lane >> 4) & 1;
    f32x16 Sacc[2]; float dnext[2];
    if (tid < 128) ((LAS float*)(lds + H_PSS + 1024))[tid] = hg_norm[tid];
    if (bx < NHU) { const int u = bx;
    const int bh = u & 63, seg = u >> 6, h = bh & 3, nci = seg_len(seg);
    const size_t rowb = (size_t)(bh >> 2) * SEQ + seg_start(seg) * 64;
    { hgrn_dma<3>(lds, HG, rowb, h, wave, lane);
        const float* dp = DCH + ((rowb >> 6) * 4 + h) * 128;
        dnext[0] = dp[64 * tt + r]; dnext[1] = dp[64 * tt + 32 + r]; }
    VM_WAIT(); HBAR();
    for (int ci = 0; ci < nci; ++ci) {
        asm volatile("s_waitcnt vmcnt(2)" ::: "memory");
        const size_t row0 = rowb + (size_t)ci * 64;
        LAS unsigned char* stg = lds + (ci & 1) * H_STAGE;
        const float dcur[2] = {dnext[0], dnext[1]};
        if (ci == 0) {
#pragma unroll
            for (int j = 0; j < 2; ++j)
#pragma unroll
                for (int i = 0; i < 16; ++i) Sacc[j][i] = 0.f;
            for (int p = 0; p < seg; ++p) {
                const int sp = bh * NSEG + p;
                const float dsg[2] = {DSEG[sp * 128 + 64 * tt + r], DSEG[sp * 128 + 64 * tt + 32 + r]};
                const float* ep = SST + (size_t)sp * 16384 + (32 * vt + 4 * hh) * 128 + 64 * tt + r;
                asm volatile("" : "+v"(ep));
#pragma unroll
                for (int j = 0; j < 2; ++j)
#pragma unroll
                    for (int i = 0; i < 16; ++i) Sacc[j][i] = Sacc[j][i] * dsg[j] + ep[(crow(i, 0)) * 128 + 32 * j];
            }
        }
        if (ci + 1 < nci) {
            const size_t row2 = row0 + 64;
            const float* dp = DCH + ((row2 >> 6) * 4 + h) * 128;
            dnext[0] = dp[64 * tt + r]; dnext[1] = dp[64 * tt + 32 + r];
            hgrn_dma<3>(lds + ((ci + 1) & 1) * H_STAGE, HG, row2, h, wave, lane);
        }
        const int nt_ = tid >> 3, nv0 = (tid & 7) * 16;
        const size_t nrow = row0 + nt_;
        const bf16* gp = HG + (size_t)3 * ((size_t)M * 512) + ((size_t)((nrow >> 12) * 4 + h) * SEQ + (nrow & (SEQ - 1))) * 128 + nv0;
        const v4u gq0 = *(const v4u*)gp, gq1 = *(const v4u*)(gp + 8);
#pragma unroll
        for (int j = 0; j < 2; ++j) { const int kk = 32 * (2 * tt + j) + r;
#pragma unroll
            for (int i = 0; i < 16; ++i) { Sacc[j][i] *= dcur[j]; const int v = 32 * vt + crow(i, hh);
                *(LAS bf16*)(lds + H_ST + v * 256 + (((kk >> 3) ^ fsw(v)) << 4) + (kk & 7) * 2) = (bf16)cvtpk_s(Sacc[j][i], 0.f); } }
        HBAR();
        pg8::bf16x8 qb[8];
#pragma unroll
        for (int ks = 0; ks < 8; ++ks) qb[ks] = rowfrag(stg + H_QT, 32 * tt + r, ks, hh);
        pg8::bf16x8 vf[2][2];
        hgrn_vfrags(stg, vf, vt, hh, tq, tp, tblk);
        f32x16 O;
#pragma unroll
        for (int i = 0; i < 16; ++i) O[i] = 0.f;
#pragma unroll
        for (int ks = 0; ks < 8; ++ks) O = MFMA32(rowfrag(lds + H_ST, 32 * vt + r, ks, hh), qb[ks], O);
#pragma unroll
        for (int st = 0; st < 2; ++st) {
            if (st <= tt) {
                f32x16 X;
#pragma unroll
                for (int i = 0; i < 16; ++i) X[i] = 0.f;
#pragma unroll
                for (int ks = 0; ks < 8; ++ks) X = MFMA32(rowfrag(stg + H_KH, 32 * st + r, ks, hh), qb[ks], X);
                if (st == tt) {
#pragma unroll
                    for (int i = 0; i < 16; ++i) X[i] = (crow(i, hh) <= r) ? X[i] : 0.f;
                }
#pragma unroll
                for (int s_ = 0; s_ < 2; ++s_) O = MFMA32(vf[st][s_], pack_step(X, s_), O);
            }
        }
        if (ci + 1 < nci) hgrn_update(stg, Sacc, vf, tt, hh, tq, tp, tblk);
        { float ss = 0.f;
#pragma unroll
            for (int i = 0; i < 16; ++i) ss += O[i] * O[i];
            ss = xadd32(ss);
            const int t = 32 * tt + r;
#pragma unroll
            for (int g4 = 0; g4 < 4; ++g4) { v2u w; w.x = cvtpk_s(O[4 * g4], O[4 * g4 + 1]); w.y = cvtpk_s(O[4 * g4 + 2], O[4 * g4 + 3]);
                *(LAS v2u*)(lds + H_OB + t * 256 + (((4 * vt + g4) ^ (t & 15)) << 4) + 8 * hh) = w; }
            if (hh == 0) ((LAS float*)(lds + H_PSS))[vt * 64 + t] = ss; }
        HBAR();
        { const int t = nt_, v0 = nv0;
            const LAS float* PSS = (const LAS float*)(lds + H_PSS);
            const float ss = (PSS[t] + PSS[64 + t]) + (PSS[128 + t] + PSS[192 + t]);
            const float rstd = __builtin_amdgcn_rsqf(ss * (1.0f / 128.0f) + EPS);
            bf16* yp = YB + nrow * 1024 + 512 + h * 128 + v0;
#pragma unroll
            for (int q8 = 0; q8 < 2; ++q8) {
                float gv[8], ov[8]; unpack8(q8 ? gq1 : gq0, gv);
                const int ca = (v0 + 8 * q8) >> 3;
                float oo[8]; unpack8(*(const LAS v4u*)(lds + H_OB + t * 256 + ((ca ^ (t & 15)) << 4)), oo);
                const f32x4 na = *(const LAS f32x4*)(lds + H_PSS + 1024 + (v0 + 8 * q8) * 4), nb = *(const LAS f32x4*)(lds + H_PSS + 1024 + (v0 + 8 * q8 + 4) * 4);
#pragma unroll
                for (int i = 0; i < 4; ++i) { ov[i] = oo[i] * rstd * na[i] * gv[i]; ov[4 + i] = oo[4 + i] * rstd * nb[i] * gv[4 + i]; }
                *(v4u*)(yp + 8 * q8) = pack8(ov);
            }
        }
    }
    VM_WAIT(); HBAR();
    }
}
__global__ void __launch_bounds__(NTHR, 2) fwd_kernel(Args args) {
    extern __shared__ __attribute__((aligned(16))) unsigned char lds_raw[];
    LAS unsigned char* lds = (LAS unsigned char*)lds_raw;
    volatile LAS unsigned* MISC = (volatile LAS unsigned*)(lds + MISC_OFF);
    const int tid = threadIdx.x;
#define OPTID() ({ int t_ = threadIdx.x; asm volatile("" : "+v"(t_)); t_; })
    const int G = gridDim.x, bx = blockIdx.x;
    unsigned char* ws = args.ws;
    gu32* ctl = (gu32*)(ws + WS_CTL);
    const float* x = args.in[0]; const float* p = args.in[1]; const float* norm_mix = args.in[2]; const float* w_in = args.in[3]; const float* hg_lb = args.in[4]; const float* hg_norm = args.in[5];
    const float* w_a_up = args.in[6]; const float* w_b_up = args.in[7]; const float* w_out = args.in[8]; const float* norm_ffn = args.in[9]; const float* w_gu = args.in[10]; const float* w_down = args.in[11];
    const float* norm_ple = args.in[12]; const float* w_pe = args.in[13]; const float* w_pg = args.in[14]; const float* norm_final = args.in[15];
    float* out = args.out;
    bf16* WIN = (bf16*)(ws + WS_WIN); bf16* WGU = (bf16*)(ws + WS_WGU); bf16* WDN = (bf16*)(ws + WS_WDN); bf16* WOUT = (bf16*)(ws + WS_WOUT); bf16* WPG = (bf16*)(ws + WS_WPG);
    bf16* WA = (bf16*)(ws + WS_WA); bf16* WB = (bf16*)(ws + WS_WB); bf16* WPE = (bf16*)(ws + WS_WPE);
    bf16* PB = (bf16*)(ws + WS_PB); bf16* XB = (bf16*)(ws + WS_XB); bf16* YA = (bf16*)out; bf16* YB = (bf16*)out;
    float* S0 = (float*)(ws + WS_RSTD0);
    bf16* ATT = (bf16*)(ws + WS_ATT); bf16* HG = (bf16*)(ws + WS_HG); bf16* GT = (bf16*)(ws + WS_GT);
    float* LSEB = (float*)(ws + WS_LSE);
    float* EST = (float*)(ws + WS_EST); float* DSEG = (float*)(ws + WS_DSEG);
    float* DCH = (float*)(ws + WS_DCH);
    bf16* MRG = ATT; bf16* X1B = HG; bf16* HID = GT; bf16* X2B = ATT; bf16* PE = XB; bf16* X3B = HG;
    float* SS1 = (float*)(ctl + CW_SS1); float* SS2 = (float*)(ctl + CW_SS2); float* SS3 = (float*)(ctl + CW_SS3);

    for (int u = tid; u < (LDS_BYTES - LDSCTL_OFF) / 4; u += NTHR) ((LAS unsigned*)(lds + LDSCTL_OFF))[u] = 0u;
    __syncthreads();
    XcdBarrier bar = xcd_barrier_post((unsigned*)(ctl + CW_BAR), MISC + 8);

    {
        const int tid0 = OPTID(), lane = tid0 & 63, wave = __builtin_amdgcn_readfirstlane(tid0 >> 6);
        LAS float* scr = (LAS float*)(lds + RING_OFF + wave * 16384);
        const int gw = bx * NWAVES + wave, NGW = G * NWAVES;
        constexpr int I_IN = (D / 64) * (NIN / 32), I_GU = I_IN, I_DN = (FF / 64) * (D / 32), I_SQ = (D / 64) * (D / 32), I_AB = (512 / 64) * (D / 32), I_PE = (PLE / 64) * (D / 32);
        constexpr int NITEMS = I_IN + I_GU + I_DN + 2 * I_SQ + 2 * I_AB + I_PE;
        for (int it = gw; it < NITEMS; it += NGW) {
            int r = it;
            if (r < I_IN) { p0_transpose_item(w_in, D, NIN, norm_mix, WIN, 2, scr, r, lane); continue; } r -= I_IN;
            if (r < I_GU) { p0_transpose_item(w_gu, D, NIN, norm_ffn, WGU, 1, scr, r, lane); continue; } r -= I_GU;
            if (r < I_DN) { p0_transpose_item(w_down, FF, D, nullptr, WDN, 0, scr, r, lane); continue; } r -= I_DN;
            if (r < I_SQ) { p0_transpose_item(w_out, D, D, nullptr, WOUT, 0, scr, r, lane); continue; } r -= I_SQ;
            if (r < I_SQ) { p0_transpose_item(w_pg, D, D, norm_ple, WPG, 0, scr, r, lane); continue; } r -= I_SQ;
            if (r < I_AB) { p0_transpose_item(w_a_up, 512, D, nullptr, WA, 0, scr, r, lane, 1024, 0); continue; } r -= I_AB;
            if (r < I_AB) { p0_transpose_item(w_b_up, 512, D, nullptr, WA, 0, scr, r, lane, 1024, 512); continue; } r -= I_AB;
            p0_transpose_item(w_pe, PLE, D, nullptr, WPE, 0, scr, r, lane);
        }
        for (int m0 = 4 * gw; m0 < M; m0 += 4 * NGW) {
            f32x4 v[4][4], pv[4];
#pragma unroll
            for (int rr = 0; rr < 4; ++rr) {
                const GAS f32x4* xr = (const GAS f32x4*)(x + (size_t)(m0 + rr) * D) + lane;
#pragma unroll
                for (int j = 0; j < 4; ++j) v[rr][j] = xr[64 * j];
                pv[rr] = ((const GAS f32x4*)(p + (size_t)(m0 + rr) * PLE))[lane];
            }
#pragma unroll
            for (int rr = 0; rr < 4; ++rr) {
                float s = 0.f;
#pragma unroll
                for (int j = 0; j < 4; ++j) s += (v[rr][j].x * v[rr][j].x + v[rr][j].y * v[rr][j].y) + (v[rr][j].z * v[rr][j].z + v[rr][j].w * v[rr][j].w);
                s = wave_sum(s);
                const float rs = __builtin_amdgcn_rsqf(s * (1.0f / D) + EPS);
                if (lane == 0) S0[m0 + rr] = (s * (1.0f / D) + EPS) * rs;
                GAS v2u* o8 = (GAS v2u*)(XB + (size_t)(m0 + rr) * D) + lane;
#pragma unroll
                for (int j = 0; j < 4; ++j) { v2u w; w.x = pg8::cvt_pk_bf16(v[rr][j].x * rs, v[rr][j].y * rs); w.y = pg8::cvt_pk_bf16(v[rr][j].z * rs, v[rr][j].w * rs); o8[64 * j] = w; }
                v2u w; w.x = pg8::cvt_pk_bf16(pv[rr].x, pv[rr].y); w.y = pg8::cvt_pk_bf16(pv[rr].z, pv[rr].w);
                ((GAS v2u*)(PB + (size_t)(m0 + rr) * PLE))[lane] = w;
            }
        }
    }
    xcd_barrier(bar);

    {
        if (0)         { const int grp = (bx >> 3) & 3;
            if (grp) { const unsigned long long t0 = __builtin_amdgcn_s_memrealtime();
                while (__builtin_amdgcn_s_memrealtime() - t0 < (unsigned long long)(grp * 750)) __builtin_amdgcn_s_sleep(8); } }
        pg8::Gemm g{XB, WIN, M, NIN, D}; pg8::StaticOrder S; S.init(M, NIN, G, bx); S.rot = (bx & 7) * 3;
        Epi<1> E{}; E.a.att = ATT; E.a.hg = HG; E.a.g = GT; E.a.hg_lb = hg_lb; E.a.dch = DCH;
        pg8::gemm_phase<Epi<1>, pg8::StaticOrder, true, true>(lds + RING_OFF, g, S, E);
    }
    xcd_barrier(bar);

#define HG_ALL() do { hgrn_passA(lds, HG, DCH, EST, DSEG, bx, G, OPTID()); xcd_barrier(bar); hgrn_passC(lds, HG, DCH, hg_norm, EST, DSEG, YB, bx, G, OPTID()); } while (0)
    HG_ALL();
    for (int u = bx; u < 256; u += G) attn16_unit(lds + RING_OFF, ATT, YA, LSEB, u >> 4, (u >> 1) & 7, u & 1, OPTID());
    __syncthreads();
    for (int u = tid; u < (LDS_BYTES - LDSCTL_OFF) / 4; u += NTHR) ((LAS unsigned*)(lds + LDSCTL_OFF))[u] = 0u;
    __syncthreads();
    xcd_barrier(bar);

    {
        pg8::SplitOrder S; S.init(M, D, G, bx);
        pg8::Gemm g{YA, WA, M, D, 512, 1024}; Epi<2> E{}; E.a.gate = GT; E.a.ob = MRG;
        pg8::gemm_phase<Epi<2>, pg8::SplitOrder, true, true>(lds + RING_OFF, g, S, E);
    }
    xcd_barrier(bar);

    {
        pg8::Gemm g{MRG, WOUT, M, D, D}; pg8::StaticOrder S; S.init(M, D, G, bx);
        Epi<4> E{}; E.a.xrb = XB; E.a.rs = S0; E.a.ob = X1B; E.a.ss = SS1;
        pg8::gemm_phase<Epi<4>, pg8::StaticOrder, true, true>(lds + RING_OFF, g, S, E);
    }
    xcd_barrier(bar);

    {
        pg8::Gemm g{X1B, WGU, M, NIN, D}; pg8::StaticOrder S; S.init(M, NIN, G, bx); S.rot = (bx & 7) * 3;
        Epi<5> E{}; E.a.rs = SS1; E.a.ob = HID;
        pg8::gemm_phase<Epi<5>, pg8::StaticOrder, true, true>(lds + RING_OFF, g, S, E);
    }
    xcd_barrier(bar);

    {
        pg8::Gemm g{HID, WDN, M, D, FF}; pg8::StaticOrder S; S.init(M, D, G, bx);
        Epi<6> E{}; E.a.xrb = X1B; E.a.ob = X2B; E.a.ss = SS2;
        pg8::gemm_phase<Epi<6>, pg8::StaticOrder, true, true>(lds + RING_OFF, g, S, E);
    }
    { pg8::StaticOrder S; S.init(M, D, G, bx); pg8::Gemm g{PB, WPE, M, D, PLE}; Epi<7> E{}; E.a.ob = PE; pg8::gemm_phase<Epi<7>, pg8::StaticOrder, true, true>(lds + RING_OFF, g, S, E); }
    xcd_barrier(bar);

    {
        pg8::StaticOrder S; S.init(M, D, G, bx);
        { pg8::Gemm g{X2B, WPG, M, D, D}; Epi<8> E{}; E.a.rs = SS2; E.a.gate = PE; E.a.xrb = X2B; E.a.ob = X3B; E.a.ss = SS3; pg8::gemm_phase<Epi<8>, pg8::StaticOrder, true, true>(lds + RING_OFF, g, S, E); }
    }
    xcd_barrier(bar);

    {
        const int tid8 = OPTID();
        const int lane = tid8 & 63, wave = __builtin_amdgcn_readfirstlane(tid8 >> 6);
        const int gw = bx * NWAVES + wave, NGW = G * NWAVES;
        const bool bad = __hip_atomic_load(ctl + CW_BAR + XB_TMO, RLX_AGENT) != 0u;
        for (int m0 = 4 * gw; m0 < M; m0 += 4 * NGW) {
            v4u xin[4][2]; float rr_[4];
#pragma unroll
            for (int q = 0; q < 4; ++q) { const v4u* xr = (const v4u*)(X3B + (size_t)(m0 + q) * D) + lane; xin[q][0] = xr[0]; xin[q][1] = xr[64]; rr_[q] = SS3[m0 + q]; }
#pragma unroll
            for (int q = 0; q < 4; ++q) {
                float r = __builtin_amdgcn_rsqf(rr_[q] * (1.0f / D) + EPS);
                if (bad) r = __builtin_nanf("");
                f32x4* orow = (f32x4*)(out + (size_t)(m0 + q) * D);
#pragma unroll
                for (int j = 0; j < 2; ++j) {
                    float v[8]; unpack8(xin[q][j], v);
                    const int c0 = 512 * j + 8 * lane;
                    const f32x4 g0 = *(const f32x4*)(norm_final + c0), g1 = *(const f32x4*)(norm_final + c0 + 4);
                    orow[(c0 >> 2)] = (f32x4){v[0] * r * g0[0], v[1] * r * g0[1], v[2] * r * g0[2], v[3] * r * g0[3]};
                    orow[(c0 >> 2) + 1] = (f32x4){v[4] * r * g1[0], v[5] * r * g1[1], v[6] * r * g1[2], v[7] * r * g1[3]};
                }
            }
        }
    }
}

extern "C" void kernel_launch(void* const* d_in, const int* in_sizes, int n_in, void* d_out, int out_size, void* d_ws, size_t ws_size, hipStream_t stream) {
    static int grid = 0;
    if (grid == 0) {
        if (n_in != 16 || out_size != M * D || ws_size < WS_END) { fprintf(stderr, "kernel_launch: unexpected shapes (n_in %d out %d ws %zu)\n", n_in, out_size, ws_size); grid = -1; return; }
        int dev = 0, cus = 0, per_cu = 0;
        if (hipGetDevice(&dev) != hipSuccess || hipDeviceGetAttribute(&cus, hipDeviceAttributeMultiprocessorCount, dev) != hipSuccess) { grid = -1; return; }
        if (hipFuncSetAttribute((const void*)fwd_kernel, hipFuncAttributeMaxDynamicSharedMemorySize, LDS_BYTES) != hipSuccess) { fprintf(stderr, "kernel_launch: hipFuncSetAttribute failed\n"); grid = -1; return; }
        if (hipOccupancyMaxActiveBlocksPerMultiprocessor(&per_cu, (const void*)fwd_kernel, NTHR, LDS_BYTES) != hipSuccess || per_cu < 1) fprintf(stderr, "kernel_launch: occupancy query says %d\n", per_cu);
        (void)hipGetLastError();
        if (cus < NHU) { fprintf(stderr, "kernel_launch: %d CUs, the mixer-B pass needs one workgroup per (batch, head, segment) = %d\n", cus, NHU); grid = -1; return; }
        grid = cus;
    }
    if (grid < 0) return;
    (void)hipMemsetAsync((char*)d_ws + WS_CTL, 0, CTL_ZERO_BYTES, stream);
    Args a{};
    for (int i = 0; i < 16; ++i) a.in[i] = (const float*)d_in[i];
    a.out = (float*)d_out; a.ws = (unsigned char*)d_ws;
    hipLaunchKernelGGL(fwd_kernel, dim3(grid), dim3(NTHR), LDS_BYTES, stream, a);
}
```
